# Optimizing an MI355X kernel written in HIP

```python
import math
import jax, jax.numpy as jnp
from jax import lax
import numpy as np

D_MODEL = 1024
BATCH = 32
SEQ = 2048
DEPTH = 2

GRID_W = 64
CTX_LEN = 256
EPS = 1e-6

MLA_HEADS = 4
MLA_Q_LORA = 256
MLA_KV_LORA = 128
MLA_NOPE = 128
MLA_ROPE = 64
MLA_V = 128
MLA_WIDTH = MLA_HEADS * MLA_V
ROPE_BASE = 10000.0
ATTN_BLOCK = 128

HG_HEADS = 4
HG_K = 128
HG_V = 64
HG_WIDTH = HG_HEADS * HG_V
HG_CHUNK = 64

FN_GROUPS = 4
FN_GROUP_DIM = 64
FN_WIDTH = FN_GROUPS * FN_GROUP_DIM

MIX_WIDTH = MLA_WIDTH + HG_WIDTH + FN_WIDTH
FFN_HIDDEN = -(-8 * D_MODEL // (3 * 256)) * 256

O_CQ = 0
O_CKV = O_CQ + MLA_Q_LORA
O_KR = O_CKV + MLA_KV_LORA
O_HQ = O_KR + MLA_ROPE
O_HFF = O_HQ + HG_HEADS * HG_K
O_HFB = O_HFF + HG_HEADS * HG_K
O_HI = O_HFB + HG_HEADS * HG_K
O_HG = O_HI + HG_WIDTH
O_FN = O_HG + HG_WIDTH
IN_WIDTH = O_FN + FN_WIDTH

kernel_name = 'hybrid_mla_hgrn2_fnet_dit'


def rms_norm(x, g):
    xf = x.astype(jnp.float32)
    y = xf * lax.rsqrt(jnp.mean(xf * xf, axis=-1, keepdims=True) + EPS)
    return (y * g.astype(jnp.float32)).astype(x.dtype)


def modulate(x, g, shift, scale):
    return rms_norm(x, g) * (1 + scale) + shift


def axial_rope(n_tokens, dtype):
    rows = n_tokens // GRID_W
    row_pos = jnp.repeat(jnp.arange(rows, dtype=jnp.float32), GRID_W)
    col_pos = jnp.tile(jnp.arange(GRID_W, dtype=jnp.float32), rows)
    axis_dim = MLA_ROPE // 2
    inv_freq = ROPE_BASE ** (-jnp.arange(0, axis_dim, 2, dtype=jnp.float32) / axis_dim)
    ang_r = row_pos[:, None] * inv_freq
    ang_c = col_pos[:, None] * inv_freq
    ang = jnp.concatenate([ang_r, ang_r, ang_c, ang_c], axis=-1)
    return (jnp.cos(ang).astype(dtype)[None, :, None, :], jnp.sin(ang).astype(dtype)[None, :, None, :])


def apply_rope(x, cos, sin):
    r1, r2, c1, c2 = jnp.split(x, 4, axis=-1)
    rot = jnp.concatenate([-r2, r1, -c2, c1], axis=-1)
    return x * cos + rot * sin


def mla_queries(p, q_norm_g, w_uq, rope):
    b, t, _ = p.shape
    cq = rms_norm(p[..., O_CQ:O_CKV], q_norm_g)
    q = (cq @ w_uq).reshape(b, t, MLA_HEADS, MLA_NOPE + MLA_ROPE)
    q_nope, q_pe = q[..., :MLA_NOPE], q[..., MLA_NOPE:]
    if rope is not None:
        q_pe = apply_rope(q_pe, rope[0], rope[1])
    return jnp.concatenate([q_nope, q_pe], axis=-1)


def mla_keys_values(p, kv_norm_g, w_ukv, rope):
    b, t, _ = p.shape
    ckv = rms_norm(p[..., O_CKV:O_KR], kv_norm_g)
    kv = (ckv @ w_ukv).reshape(b, t, MLA_HEADS, MLA_NOPE + MLA_V)
    k_nope, v = kv[..., :MLA_NOPE], kv[..., MLA_NOPE:]
    k_pe = p[..., O_KR:O_HQ][:, :, None, :]
    if rope is not None:
        k_pe = apply_rope(k_pe, rope[0], rope[1])
    k = jnp.concatenate([k_nope, jnp.broadcast_to(k_pe, (b, t, MLA_HEADS, MLA_ROPE))], axis=-1)
    return k, v


def block_attention(q, k, v):
    b, t, h, dk = q.shape
    nb = t // ATTN_BLOCK
    qb = q.reshape(b, nb, ATTN_BLOCK, h, dk).swapaxes(0, 1)
    scale = 1.0 / math.sqrt(dk)

    def one_block(qi):
        s = jnp.einsum('bqhd,bkhd->bhqk', qi, k).astype(jnp.float32) * scale
        pr = jax.nn.softmax(s, axis=-1).astype(v.dtype)
        return jnp.einsum('bhqk,bkhd->bqhd', pr, v)

    o = lax.map(one_block, qb)
    return o.swapaxes(0, 1).reshape(b, t, h * v.shape[-1])


def chunk_gated_scan(q, k, v, log_f, s0, with_output):
    b, t, h, kd = q.shape
    n = t // HG_CHUNK

    def to_chunks(a):
        return a.reshape(b, n, HG_CHUNK, h, a.shape[-1]).swapaxes(0, 1)

    causal = jnp.tril(jnp.ones((HG_CHUNK, HG_CHUNK), dtype=bool))[None, :, :, None, None]

    def step(state, inp):
        qc, kc, vc, gc = inp
        bcum = jnp.cumsum(gc, axis=1)
        total = bcum[:, -1]
        new_state = jnp.exp(total)[..., None] * state + jnp.einsum(
            'bshk,bshv->bhkv', kc * jnp.exp(total[:, None] - bcum), vc)
        if not with_output:
            return new_state, None
        decay = jnp.exp(jnp.where(causal, bcum[:, :, None] - bcum[:, None], -jnp.inf))
        scores = jnp.einsum('bthk,btshk,bshk->bhts', qc, decay, kc)
        o = jnp.einsum('bhts,bshv->bthv', scores, vc) + jnp.einsum(
            'bthk,bhkv->bthv', qc * jnp.exp(bcum), state)
        return new_state, o

    s_fin, o = lax.scan(step, s0, (to_chunks(q), to_chunks(k), to_chunks(v), to_chunks(log_f)))
    if with_output:
        o = o.swapaxes(0, 1).reshape(b, t, h, v.shape[-1])
    return o, s_fin


def hgrn2_inputs(p, lb_fb):
    b, t, _ = p.shape
    q = jax.nn.silu(p[..., O_HQ:O_HFF].astype(jnp.float32)).reshape(b, t, HG_HEADS, HG_K)
    i = p[..., O_HI:O_HG].astype(jnp.float32).reshape(b, t, HG_HEADS, HG_V)

    def gate(z, lb):
        f = lb + (1.0 - lb) * jax.nn.sigmoid(z.astype(jnp.float32))
        return (1.0 - f).reshape(b, t, HG_HEADS, HG_K), jnp.log(f).reshape(b, t, HG_HEADS, HG_K)

    fwd = gate(p[..., O_HFF:O_HFB], lb_fb[0])
    bwd = gate(p[..., O_HFB:O_HI], lb_fb[1])
    return q, i, fwd, bwd


def hgrn2_readout(o, z_gate, gain):
    b, t = o.shape[0], o.shape[1]
    on = o * lax.rsqrt(jnp.mean(o * o, axis=-1, keepdims=True) + EPS)
    on = on * gain.astype(jnp.float32).reshape(HG_HEADS, HG_V)
    return (on.reshape(b, t, HG_WIDTH) * jax.nn.silu(z_gate.astype(jnp.float32))).astype(z_gate.dtype)


def fourier_mix(z, w):
    b, t, _ = z.shape
    zg = z.astype(jnp.float32).reshape(b, t, FN_GROUPS, FN_GROUP_DIM)
    mixed = jnp.fft.fft2(zg, axes=(1, 3), norm='ortho').real
    return mixed.reshape(b, t, FN_WIDTH).astype(z.dtype) @ w


def swiglu_ffn(h, w_gu, w_dn):
    gate, up = jnp.split(h @ w_gu, 2, axis=-1)
    return (jax.nn.silu(gate) * up) @ w_dn


def setup_inputs(seed: int = 0) -> dict:
    key = jax.random.key(seed)
    ks = jax.random.split(key, 20)
    f32 = jnp.float32

    def nrm(k, shape, scale):
        return jax.random.normal(k, shape, f32) * scale

    def gain(k, shape):
        return 1.0 + 0.02 * jax.random.normal(k, shape, f32)

    return {
        'x': nrm(ks[0], (BATCH, SEQ, D_MODEL), 1.0),
        'c': nrm(ks[1], (BATCH, D_MODEL), 1.0),
        'ctx': nrm(ks[2], (BATCH, CTX_LEN, D_MODEL), 1.0),
        'c_ctx': nrm(ks[3], (D_MODEL,), 1.0),
        'w_mod': nrm(ks[4], (DEPTH, D_MODEL, 6 * D_MODEL), D_MODEL ** -0.5),
        'b_mod': nrm(ks[5], (DEPTH, 6 * D_MODEL), 0.02),
        'norm1_g': gain(ks[6], (DEPTH, D_MODEL)),
        'norm2_g': gain(ks[7], (DEPTH, D_MODEL)),
        'w_in': nrm(ks[8], (DEPTH, D_MODEL, IN_WIDTH), D_MODEL ** -0.5),
        'q_norm_g': gain(ks[9], (DEPTH, MLA_Q_LORA)),
        'w_uq': nrm(ks[10], (DEPTH, MLA_Q_LORA, MLA_HEADS * (MLA_NOPE + MLA_ROPE)), MLA_Q_LORA ** -0.5),
        'kv_norm_g': gain(ks[11], (DEPTH, MLA_KV_LORA)),
        'w_ukv': nrm(ks[12], (DEPTH, MLA_KV_LORA, MLA_HEADS * (MLA_NOPE + MLA_V)), MLA_KV_LORA ** -0.5),
        'lb_param': nrm(ks[13], (DEPTH, 2, HG_HEADS * HG_K), 1.0),
        'hg_norm_g': gain(ks[14], (DEPTH, HG_WIDTH)),
        'w_fourier': nrm(ks[15], (DEPTH, FN_WIDTH, FN_WIDTH), FN_WIDTH ** -0.5),
        'w_out': nrm(ks[16], (DEPTH, MIX_WIDTH, D_MODEL), MIX_WIDTH ** -0.5),
        'w_gate_up': nrm(ks[17], (DEPTH, D_MODEL, 2 * FFN_HIDDEN), D_MODEL ** -0.5),
        'w_down': nrm(ks[18], (DEPTH, FFN_HIDDEN, D_MODEL), FFN_HIDDEN ** -0.5),
        'final_norm_g': gain(ks[19], (D_MODEL,)),
    }


def reference(x, c, ctx, c_ctx, w_mod, b_mod, norm1_g, norm2_g, w_in, q_norm_g, w_uq, kv_norm_g, w_ukv,
              lb_param, hg_norm_g, w_fourier, w_out, w_gate_up, w_down, final_norm_g):
    b, t, _ = x.shape
    rope = axial_rope(t, x.dtype)
    probs = jax.nn.softmax(lb_param.astype(jnp.float32), axis=0)
    lower_bounds = jnp.cumsum(probs, axis=0) - probs[0]
    s_zero = jnp.zeros((b, HG_HEADS, HG_K, HG_V), jnp.float32)
    c_act = jax.nn.silu(c)
    cc_act = jax.nn.silu(c_ctx)

    def flip(a):
        return jnp.flip(a, axis=1)

    for l in range(DEPTH):
        last = l == DEPTH - 1
        sh1, sc1, g1, sh2, sc2, g2 = jnp.split((c_act @ w_mod[l] + b_mod[l])[:, None, :], 6, axis=-1)
        csh1, csc1, cg1, csh2, csc2, cg2 = jnp.split((cc_act @ w_mod[l] + b_mod[l])[None, None, :], 6, axis=-1)

        p = modulate(x, norm1_g[l], sh1, sc1) @ w_in[l]
        pc = modulate(ctx, norm1_g[l], csh1, csc1) @ w_in[l]

        k_lat, v_lat = mla_keys_values(p, kv_norm_g[l], w_ukv[l], rope)
        k_ctx, v_ctx = mla_keys_values(pc, kv_norm_g[l], w_ukv[l], None)
        q_lat = mla_queries(p, q_norm_g[l], w_uq[l], rope)
        attn = block_attention(q_lat, jnp.concatenate([k_lat, k_ctx], axis=1),
                               jnp.concatenate([v_lat, v_ctx], axis=1))

        lb_fb = lower_bounds[l]
        qc, ic, (kcf, lcf), (kcb, lcb) = hgrn2_inputs(pc, lb_fb)
        o_cf, s_cf = chunk_gated_scan(qc, kcf, ic, lcf, s_zero, not last)
        o_cb, s_cb = chunk_gated_scan(flip(qc), flip(kcb), flip(ic), flip(lcb), s_zero, not last)
        ql, il, (klf, llf), (klb, llb) = hgrn2_inputs(p, lb_fb)
        o_lf, _ = chunk_gated_scan(ql, klf, il, llf, s_cf, True)
        o_lb, _ = chunk_gated_scan(flip(ql), flip(klb), flip(il), flip(llb), s_cb, True)
        hg = hgrn2_readout(o_lf + flip(o_lb), p[..., O_HG:O_FN], hg_norm_g[l])

        fn = fourier_mix(p[..., O_FN:IN_WIDTH], w_fourier[l])

        y = jnp.concatenate([attn, hg, fn], axis=-1) @ w_out[l]
        x_new = x + g1 * y
        x_new = x_new + g2 * swiglu_ffn(modulate(x_new, norm2_g[l], sh2, sc2), w_gate_up[l], w_down[l])

        if not last:
            attn_c = block_attention(mla_queries(pc, q_norm_g[l], w_uq[l], None), k_ctx, v_ctx)
            hg_c = hgrn2_readout(o_cf + flip(o_cb), pc[..., O_HG:O_FN], hg_norm_g[l])
            fn_c = fourier_mix(pc[..., O_FN:IN_WIDTH], w_fourier[l])
            yc = jnp.concatenate([attn_c, hg_c, fn_c], axis=-1) @ w_out[l]
            ctx = ctx + cg1 * yc
            ctx = ctx + cg2 * swiglu_ffn(modulate(ctx, norm2_g[l], csh2, csc2), w_gate_up[l], w_down[l])
        x = x_new

    return rms_norm(x, final_norm_g)
```

```cpp
#include <hip/hip_runtime.h>
#include <hip/hip_cooperative_groups.h>
#include <cstdio>
#include <cstdint>
namespace cg = cooperative_groups;

#ifndef MK_MULTI
#define MK_MULTI 0
#endif

#ifndef ONLY_MASK
#define ONLY_MASK 0x7ffff
#endif
#define EN(k) (((ONLY_MASK) >> (k)) & 1)
#ifndef DUP
#define DUP 0
#endif
#define REP(bit) for (int rep_ = 0; rep_ < (((DUP) >> (bit)) & 1) + 1; ++rep_)
#define LAS __attribute__((address_space(3)))
typedef unsigned short bf16_t;
typedef short bf16x8 __attribute__((ext_vector_type(8)));
typedef short s16x4 __attribute__((ext_vector_type(4)));
typedef float f32x4 __attribute__((ext_vector_type(4)));
typedef float f32x16 __attribute__((ext_vector_type(16)));
typedef unsigned u32x4 __attribute__((ext_vector_type(4)));
typedef unsigned u32x2 __attribute__((ext_vector_type(2)));

constexpr int NB = 32, TL = 2048, TC = 256, NT = 2304, MR = NB * NT, DM = 1024;
constexpr int INW = 2752, INP = 2816, FF = 2816;
constexpr int O_CKV = 256, O_KR = 384, O_HQ = 448, O_HFF = 960, O_HFB = 1472, O_HI = 1984, O_HG = 2240, O_FN = 2496;
constexpr float EPS = 1e-6f;
constexpr int KP = 200;
constexpr float QSCALE = 0.07216878364870322f * 1.4426950408889634f;

constexpr size_t MiB = 1u << 20;
constexpr size_t W_WIN = 0;
constexpr size_t W_WGU = W_WIN + 2ull * INP * DM * 2;
constexpr size_t W_WDN = W_WGU + 2ull * 5632 * DM * 2;
constexpr size_t W_WOUT = W_WDN + 2ull * DM * FF * 2;
constexpr size_t W_WS = W_WOUT + 2ull * DM * DM * 2;
constexpr size_t W_DM = W_WS + 768ull * INP * 2;
constexpr size_t W_DC = W_DM + 2048ull * 4096 * 2;
constexpr size_t W_COS = W_DC + 256ull * 512 * 2;
constexpr size_t W_SIN = W_COS + 2048ull * 32 * 4;
constexpr size_t W_MOD = W_SIN + 2048ull * 32 * 4;
constexpr size_t W_STAT = W_MOD + 2ull * 33 * 6144 * 4;
constexpr size_t W_OB = (W_STAT + (size_t)MR * 8 * 4 + 4095) / 4096 * 4096;
constexpr size_t W_ZC = W_OB + (size_t)MR * 256 * 2;
constexpr size_t W_ZCC = W_ZC + 32ull * 512 * 2048 * 2;
constexpr size_t W_VT = W_ZCC + 32ull * 512 * 256 * 2;
constexpr size_t W_K = W_VT + 32ull * 512 * NT * 2;
constexpr size_t W_Q = W_K + 128ull * NT * KP * 2;
constexpr size_t W_XC = W_Q + 128ull * NT * 192 * 2;
constexpr size_t W_P = W_XC + (size_t)MR * DM * 2;
constexpr size_t W_CTL = W_P + (size_t)MR * INP * 2;
constexpr size_t CTL_BYTES = 16384;
constexpr size_t W_END = W_CTL + CTL_BYTES;

constexpr int LDS_BYTES = 147456;
constexpr int NPHASE = 18;

__device__ __forceinline__ unsigned cvt_pk(float lo, float hi) { unsigned r; asm volatile("v_cvt_pk_bf16_f32 %0, %1, %2" : "=v"(r) : "v"(lo), "v"(hi)); return r; }
__device__ __forceinline__ unsigned f2bf(float f) { unsigned u = __builtin_bit_cast(unsigned, f); return (u + 0x7fffu + ((u >> 16) & 1u)) >> 16; }
__device__ __forceinline__ float bf2f(unsigned short h) { return __builtin_bit_cast(float, (unsigned)h << 16); }
__device__ __forceinline__ float bflo(unsigned w) { return __builtin_bit_cast(float, w << 16); }
__device__ __forceinline__ float bfhi(unsigned w) { return __builtin_bit_cast(float, w & 0xffff0000u); }
__device__ __forceinline__ float wave_sum(float v) {
#pragma unroll
    for (int o = 1; o < 64; o <<= 1) v += __shfl_xor(v, o);
    return v;
}
__device__ __forceinline__ float silu_f(float x) { return x / (1.f + __expf(-x)); }
__device__ __forceinline__ float sigm_f(float x) { return 1.f / (1.f + __expf(-x)); }

namespace pg8 {
constexpr int BM = 256, BK = 64, HALF = 128, HTB = HALF * BK * 2, NXCD = 8, WGM = 8;
__device__ __forceinline__ int lds_byte(int r, int c) { const int st = (r >> 4) * 2 + (c >> 5), rr = r & 15, cc = c & 31, ob = rr * 64 + cc * 2; return st * 1024 + (ob ^ (((ob >> 9) & 1) << 5)); }
__device__ __forceinline__ void stage_rc(int b, int& R, int& C) { const int st = b / 1024, sb = b % 1024, swz = sb ^ (((sb >> 9) & 1) << 5); R = (st >> 1) * 16 + swz / 64; C = (st & 1) * 32 + (swz % 64) / 2; }

__device__ __forceinline__ int perm32(int rho) { const int n = rho >> 4, i = rho & 15; return 8 * (i >> 2) + 4 * n + (i & 3); }
struct Unit { int pb, pm, pn; };
struct Gemm { const bf16_t* A; const bf16_t* Bt; long sA, sB; int ld, K, nb, nM, nN; };
struct Order {
    int nM, nN, per, nwg, G, c;
    __device__ __forceinline__ void init(const Gemm& g, int G_, int c_) { nM = g.nM; nN = g.nN; per = nM * nN; nwg = per * g.nb; G = G_; c = c_; }
    __device__ __forceinline__ bool next(int i, Unit& u) const {
        const long L = (long)i * G + c; if (L >= nwg) return false;
        int w = (int)L; { const int q = nwg / NXCD, r = nwg % NXCD, xcd = w % NXCD, off = w / NXCD; w = (xcd < r ? xcd * (q + 1) : r * (q + 1) + (xcd - r) * q) + off; }
        u.pb = w / per; w -= u.pb * per;
        const int nig = WGM * nN, gid = w / nig, fm = gid * WGM, gsz = (nM - fm) < WGM ? (nM - fm) : WGM;
        u.pm = fm + ((w % nig) % gsz); u.pn = (w % nig) / gsz; return true;
    }
};
template <class Epi>
__device__ __forceinline__ void gemm_phase(LAS unsigned char* lds, const Gemm g, int G, int c, const Epi& E) {
    int tid = threadIdx.x; asm volatile("" : "+v"(tid));
    const int wid = __builtin_amdgcn_readfirstlane(tid >> 6), lane = tid & 63, wr = wid >> 2, wc = wid & 3, fr = lane & 15, fq = lane >> 4;
    const int nt = g.K / BK;
    Order S; S.init(g, G, c);
    unsigned voffA[2], voffB[2];
#pragma unroll
    for (int i = 0; i < 2; ++i) { int R, C; stage_rc(tid * 16 + i * 8192, R, C); const int Rb = Epi::PERM ? ((R & ~31) + perm32(R & 31)) : R;
        voffA[i] = (unsigned)(R * g.ld + C) * 2u; voffB[i] = Epi::PERM ? (unsigned)(Rb * g.ld + C) * 2u : voffA[i]; }
    const size_t kstep = (size_t)(BK * 2);
    const size_t hstepA = (size_t)HALF * g.ld * 2, hstepB = hstepA;
    const unsigned ldsw = (unsigned)wid * 1024u;
    const int aoff = lds_byte(wr * 64 + fr, fq * 8), boff = lds_byte(wc * 32 + fr, fq * 8);
#define PG8_SA(b, h) (((b) * 2 + (h)) * HTB)
#define PG8_SB(b, h) ((4 + (b) * 2 + (h)) * HTB)
#define PG8_STAGE(bufoff, gbase, voff) do { _Pragma("unroll") for (int _i = 0; _i < 2; ++_i) \
        __builtin_amdgcn_global_load_lds((const unsigned*)((const char*)(gbase) + (voff)[_i]), (LAS unsigned*)(lds + (bufoff) + ldsw + _i * 8192), 16, 0, 0); } while (0)
#define PG8_LDA(dst, b, h) do { _Pragma("unroll") for (int m = 0; m < 4; ++m) _Pragma("unroll") for (int k = 0; k < 2; ++k) dst[m][k] = *(const LAS bf16x8*)(lds + PG8_SA(b, h) + aoff + m * 2048 + k * 1024); } while (0)
#define PG8_LDB(dst, b, h) do { _Pragma("unroll") for (int n = 0; n < 2; ++n) _Pragma("unroll") for (int k = 0; k < 2; ++k) dst[n][k] = *(const LAS bf16x8*)(lds + PG8_SB(b, h) + boff + n * 2048 + k * 1024); } while (0)
#define PG8_MMA(ai, bj, At, Bt) do { __builtin_amdgcn_s_setprio(1); _Pragma("unroll") for (int m = 0; m < 4; ++m) _Pragma("unroll") for (int n = 0; n < 2; ++n) _Pragma("unroll") for (int k = 0; k < 2; ++k) \
        acc[ai][bj][m][n] = __builtin_amdgcn_mfma_f32_16x16x32_bf16(Bt[n][k], At[m][k], acc[ai][bj][m][n], 0, 0, 0); __builtin_amdgcn_s_setprio(0); } while (0)
#define PG8_WAIT_V(n) asm volatile("s_waitcnt vmcnt(" #n ")" ::: "memory")
#define PG8_WAIT_L(n) asm volatile("s_waitcnt lgkmcnt(" #n ")" ::: "memory")
#define PG8_BAR __builtin_amdgcn_s_barrier()
#define PG8_SCHED __builtin_amdgcn_sched_barrier(0)
    Unit cur, nxt; int ui = 0;
    if (!S.next(0, cur)) return;
    f32x4 acc[2][2][4][2];
#pragma unroll
    for (int a = 0; a < 2; ++a)
#pragma unroll
        for (int b = 0; b < 2; ++b)
#pragma unroll
            for (int m = 0; m < 4; ++m)
#pragma unroll
                for (int n = 0; n < 2; ++n) acc[a][b][m][n] = (f32x4){0.f, 0.f, 0.f, 0.f};
    bf16x8 At[4][2], B0[2][2], B1[2][2];
    const char* cA = (const char*)(g.A + (size_t)cur.pb * g.sA) + (size_t)cur.pm * 2 * hstepA;
    const char* cB = (const char*)(g.Bt + (size_t)cur.pb * g.sB) + (size_t)cur.pn * 2 * hstepB;
    PG8_STAGE(PG8_SB(0, 0), cB, voffB); PG8_STAGE(PG8_SB(0, 1), cB + hstepB, voffB); PG8_STAGE(PG8_SA(0, 0), cA, voffA); PG8_STAGE(PG8_SA(0, 1), cA + hstepA, voffA);
    if (wr == 1) PG8_BAR;
    PG8_WAIT_V(2); PG8_BAR;
    PG8_STAGE(PG8_SB(1, 0), cB + kstep, voffB); PG8_STAGE(PG8_SA(1, 0), cA + kstep, voffA); PG8_STAGE(PG8_SB(1, 1), cB + hstepB + kstep, voffB);
    PG8_WAIT_V(6); PG8_BAR;
    for (;;) {
        const bool has_next = S.next(ui + 1, nxt);
        const char* nA = has_next ? (const char*)(g.A + (size_t)nxt.pb * g.sA) + (size_t)nxt.pm * 2 * hstepA : cA;
        const char* nB = has_next ? (const char*)(g.Bt + (size_t)nxt.pb * g.sB) + (size_t)nxt.pn * 2 * hstepB : cB;
#pragma nounroll
        for (int t = 0; t < nt; t += 2) {
            const bool last = (t == nt - 2);
            const char* a1 = cA + (size_t)(t + 1) * kstep;
            const char* a2 = last ? nA : cA + (size_t)(t + 2) * kstep; const char* b2 = last ? nB : cB + (size_t)(t + 2) * kstep;
            const char* a3 = a2 + kstep; const char* b3 = b2 + kstep;
            PG8_LDB(B0, 0, 0); PG8_LDB(B1, 0, 1); PG8_SCHED; PG8_LDA(At, 0, 0); PG8_STAGE(PG8_SA(1, 1), a1 + hstepA, voffA);
            PG8_WAIT_V(8); PG8_WAIT_L(0); PG8_BAR; PG8_MMA(0, 0, At, B0); PG8_MMA(0, 1, At, B1); PG8_BAR; PG8_SCHED;
            PG8_LDA(At, 0, 1); PG8_STAGE(PG8_SB(0, 0), b2, voffB); PG8_STAGE(PG8_SB(0, 1), b2 + hstepB, voffB); PG8_STAGE(PG8_SA(0, 0), a2, voffA);
            PG8_WAIT_V(8); PG8_WAIT_L(0); PG8_BAR; PG8_MMA(1, 0, At, B0); PG8_MMA(1, 1, At, B1); PG8_BAR; PG8_SCHED;
            PG8_LDB(B0, 1, 0); PG8_LDB(B1, 1, 1); PG8_SCHED; PG8_LDA(At, 1, 0); PG8_STAGE(PG8_SA(0, 1), a2 + hstepA, voffA);
            PG8_WAIT_V(8); PG8_WAIT_L(0); PG8_BAR; PG8_MMA(0, 0, At, B0); PG8_MMA(0, 1, At, B1); PG8_BAR; PG8_SCHED;
            PG8_LDA(At, 1, 1); PG8_STAGE(PG8_SB(1, 0), b3, voffB); PG8_STAGE(PG8_SB(1, 1), b3 + hstepB, voffB); PG8_STAGE(PG8_SA(1, 0), a3, voffA);
            PG8_WAIT_V(8); PG8_WAIT_L(0); PG8_BAR; PG8_MMA(1, 0, At, B0); PG8_MMA(1, 1, At, B1); PG8_BAR; PG8_SCHED;
        }
        if (wr == 0) PG8_BAR;
        { int l2 = lane; asm volatile("" : "+v"(l2)); E(acc, cur, wr, wc, l2 & 15, l2 >> 4); }
        if (!has_next) break;
#pragma unroll
        for (int a = 0; a < 2; ++a)
#pragma unroll
            for (int b = 0; b < 2; ++b)
#pragma unroll
                for (int m = 0; m < 4; ++m)
#pragma unroll
                    for (int n = 0; n < 2; ++n) acc[a][b][m][n] = (f32x4){0.f, 0.f, 0.f, 0.f};
        cur = nxt; cA = nA; cB = nB; ++ui;
        if (wr == 1) PG8_BAR;
    }
    PG8_WAIT_V(0);
    PG8_BAR;
#undef PG8_SA
#undef PG8_SB
#undef PG8_STAGE
#undef PG8_LDA
#undef PG8_LDB
#undef PG8_MMA
#undef PG8_WAIT_V
#undef PG8_WAIT_L
#undef PG8_BAR
#undef PG8_SCHED
}

typedef f32x4 Acc[2][2][4][2];
struct EpiP {
    static constexpr bool PERM = true;
    bf16_t* P; float* stats;
    __device__ __forceinline__ void operator()(const Acc& acc, const Unit& u, int wr, int wc, int fr, int fq) const {
        const size_t Rb = (size_t)u.pb * NT + u.pm * 256 + wr * 64 + fr; const int col0 = u.pn * 256 + wc * 32 + 8 * fq;
#pragma unroll
        for (int ai = 0; ai < 2; ++ai)
#pragma unroll
            for (int m = 0; m < 4; ++m) { const size_t R = Rb + ai * 128 + m * 16; bf16_t* rowp = P + R * INP + col0;
#pragma unroll
                for (int bj = 0; bj < 2; ++bj) { const f32x4 v0 = acc[ai][bj][m][0], v1 = acc[ai][bj][m][1]; u32x4 w; w.x = cvt_pk(v0[0], v0[1]); w.y = cvt_pk(v0[2], v0[3]); w.z = cvt_pk(v1[0], v1[1]); w.w = cvt_pk(v1[2], v1[3]);
                    *(u32x4*)(rowp + bj * 128) = w; }
                if (u.pn < 2) { float s = 0.f;
#pragma unroll
                    for (int n = 0; n < 2; ++n) { const f32x4 v = acc[ai][0][m][n]; s += (v[0] * v[0] + v[1] * v[1]) + (v[2] * v[2] + v[3] * v[3]); }
                    if (u.pn == 0) {
#pragma unroll
                        for (int n = 0; n < 2; ++n) { const f32x4 v = acc[ai][1][m][n]; s += (v[0] * v[0] + v[1] * v[1]) + (v[2] * v[2] + v[3] * v[3]); } }
                    s += __shfl_xor(s, 16); s += __shfl_xor(s, 32);
                    if (fq == 0) stats[R * 8 + u.pn * 4 + wc] = s; } }
    }
};
template <bool ISQ> struct EpiQK {
    static constexpr bool PERM = true;
    bf16_t* O; int pitch; const float* stats; const float* cosT; const float* sinT;
    __device__ __forceinline__ void operator()(const Acc& acc, const Unit& u, int wr, int wc, int fr, int fq) const {
#pragma unroll
        for (int ai = 0; ai < 2; ++ai)
#pragma unroll
            for (int m = 0; m < 4; ++m) { const int row = u.pm * 256 + ai * 128 + wr * 64 + m * 16 + fr; const size_t R = (size_t)u.pb * NT + row;
                const f32x4 sa = *(const f32x4*)(stats + R * 8 + (ISQ ? 0 : 4));
                float rr = rsqrtf(((sa[0] + sa[1]) + (sa[2] + sa[3])) * (ISQ ? (1.f / 256.f) : (1.f / 128.f)) + EPS); if (ISQ) rr *= QSCALE;
#pragma unroll
                for (int bj = 0; bj < 2; ++bj) { const int cg_ = u.pn * 256 + bj * 128 + wc * 32; const int h = cg_ / 192, d0 = cg_ - h * 192;
                    f32x4 a = acc[ai][bj][m][0], b = acc[ai][bj][m][1];
                    if (d0 < 128) { a = a * rr; b = b * rr; }
                    else { if (ISQ) { a = a * rr; b = b * rr; }
                        f32x4 pa, pb;
#pragma unroll
                        for (int i = 0; i < 4; ++i) { pa[i] = __shfl_xor(a[i], 32); pb[i] = __shfl_xor(b[i], 32); }
                        if (row < TL) { const int ti = row * 32 + ((d0 - 128) >> 5) * 16 + 8 * (fq & 1); const float sg = fq < 2 ? -1.f : 1.f;
                            const f32x4 c0 = *(const f32x4*)(cosT + ti), c1 = *(const f32x4*)(cosT + ti + 4), s0 = *(const f32x4*)(sinT + ti) * sg, s1 = *(const f32x4*)(sinT + ti + 4) * sg;
                            a = a * c0 + pa * s0; b = b * c1 + pb * s1; } }
                    bf16_t* dst = O + ((size_t)(u.pb * 4 + h) * NT + row) * pitch + d0 + 8 * fq;
                    u32x4 w; w.x = cvt_pk(a[0], a[1]); w.y = cvt_pk(a[2], a[3]); w.z = cvt_pk(b[0], b[1]); w.w = cvt_pk(b[2], b[3]); *(u32x4*)dst = w; } }
    }
};
struct EpiVt {
    static constexpr bool PERM = true;
    bf16_t* Vt; const float* stats;
    __device__ __forceinline__ void operator()(const Acc& acc, const Unit& u, int wr, int wc, int fr, int fq) const {
        f32x4 rk[2][2];
#pragma unroll
        for (int bj = 0; bj < 2; ++bj)
#pragma unroll
            for (int n = 0; n < 2; ++n) { const int col = u.pn * 256 + bj * 128 + wc * 32 + 8 * fq + 4 * n;
#pragma unroll
                for (int i = 0; i < 4; ++i) { const f32x4 sa = *(const f32x4*)(stats + ((size_t)u.pb * NT + col + i) * 8 + 4); rk[bj][n][i] = rsqrtf(((sa[0] + sa[1]) + (sa[2] + sa[3])) * (1.f / 128.f) + EPS); } }
#pragma unroll
        for (int ai = 0; ai < 2; ++ai)
#pragma unroll
            for (int m = 0; m < 4; ++m) { const int row = u.pm * 256 + ai * 128 + wr * 64 + m * 16 + fr; bf16_t* rowp = Vt + ((size_t)u.pb * 512 + row) * NT + u.pn * 256 + wc * 32 + 8 * fq;
#pragma unroll
                for (int bj = 0; bj < 2; ++bj) { const f32x4 v0 = acc[ai][bj][m][0] * rk[bj][0], v1 = acc[ai][bj][m][1] * rk[bj][1]; u32x4 w; w.x = cvt_pk(v0[0], v0[1]); w.y = cvt_pk(v0[2], v0[3]); w.z = cvt_pk(v1[0], v1[1]); w.w = cvt_pk(v1[2], v1[3]);
                    *(u32x4*)(rowp + bj * 128) = w; } }
    }
};
template <bool PM> struct EpiBf {
    static constexpr bool PERM = PM;
    bf16_t* O; long sO; int ldc, coff; bf16_t* O2; long sO2; int ldc2, split;
    __device__ __forceinline__ void operator()(const Acc& acc, const Unit& u, int wr, int wc, int fr, int fq) const {
        const bool second = u.pn >= split; bf16_t* base = second ? O2 + (size_t)u.pb * sO2 : O + (size_t)u.pb * sO + coff; const int ld = second ? ldc2 : ldc;
        const int col0 = (second ? u.pn - split : u.pn) * 256 + wc * 32 + (PM ? 8 : 4) * fq;
#pragma unroll
        for (int ai = 0; ai < 2; ++ai)
#pragma unroll
            for (int m = 0; m < 4; ++m) { const int row = u.pm * 256 + ai * 128 + wr * 64 + m * 16 + fr; bf16_t* rowp = base + (size_t)row * ld + col0;
#pragma unroll
                for (int bj = 0; bj < 2; ++bj) { const f32x4 v0 = acc[ai][bj][m][0], v1 = acc[ai][bj][m][1]; u32x4 w; w.x = cvt_pk(v0[0], v0[1]); w.y = cvt_pk(v0[2], v0[3]); w.z = cvt_pk(v1[0], v1[1]); w.w = cvt_pk(v1[2], v1[3]);
                    if (PM) *(u32x4*)(rowp + bj * 128) = w; else { *(u32x2*)(rowp + bj * 128) = (u32x2){w.x, w.y}; *(u32x2*)(rowp + bj * 128 + 16) = (u32x2){w.z, w.w}; } } }
    }
};
template <bool INF32> struct EpiRes {
    static constexpr bool PERM = true;
    const float* inL; const float* inC; const bf16_t* inB; bf16_t* outB; const float* gate;
    __device__ __forceinline__ void operator()(const Acc& acc, const Unit& u, int wr, int wc, int fr, int fq) const {
        const bool isc = u.pm == 8;
        const size_t rb = isc ? (size_t)u.pb * TC : (size_t)u.pb * TL + u.pm * 256;
        const float* in = (isc ? inC : inL) + rb * DM; const float* gp = gate + (isc ? 32 : u.pb) * 6144;
        const int col0 = u.pn * 256 + wc * 32 + 8 * fq; const size_t Rg = (size_t)u.pb * NT + u.pm * 256;
        f32x4 gv[2][2];
#pragma unroll
        for (int bj = 0; bj < 2; ++bj)
#pragma unroll
            for (int n = 0; n < 2; ++n) gv[bj][n] = *(const f32x4*)(gp + col0 + bj * 128 + n * 4);
#pragma unroll
        for (int ai = 0; ai < 2; ++ai)
#pragma unroll
            for (int m = 0; m < 4; ++m) { const int rl = ai * 128 + wr * 64 + m * 16 + fr; const size_t off = (size_t)rl * DM + col0; const size_t boff = (Rg + rl) * DM + col0;
#pragma unroll
                for (int bj = 0; bj < 2; ++bj) { f32x4 x0, x1;
                    if (INF32) { x0 = *(const f32x4*)(in + off + bj * 128); x1 = *(const f32x4*)(in + off + bj * 128 + 4); }
                    else { const u32x4 q = *(const u32x4*)(inB + boff + bj * 128); x0 = (f32x4){bflo(q.x), bfhi(q.x), bflo(q.y), bfhi(q.y)}; x1 = (f32x4){bflo(q.z), bfhi(q.z), bflo(q.w), bfhi(q.w)}; }
                    x0 = x0 + gv[bj][0] * acc[ai][bj][m][0]; x1 = x1 + gv[bj][1] * acc[ai][bj][m][1];
                    u32x4 w; w.x = cvt_pk(x0[0], x0[1]); w.y = cvt_pk(x0[2], x0[3]); w.z = cvt_pk(x1[0], x1[1]); w.w = cvt_pk(x1[2], x1[3]); *(u32x4*)(outB + boff + bj * 128) = w; } }
    }
};
struct EpiGU {
    static constexpr bool PERM = true;
    bf16_t* H;
    __device__ __forceinline__ void operator()(const Acc& acc, const Unit& u, int wr, int wc, int fr, int fq) const {
        const size_t Rb = (size_t)u.pb * NT + u.pm * 256 + wr * 64 + fr; const int col0 = u.pn * 128 + wc * 32 + 8 * fq;
#pragma unroll
        for (int ai = 0; ai < 2; ++ai)
#pragma unroll
            for (int m = 0; m < 4; ++m) { bf16_t* rowp = H + (Rb + ai * 128 + m * 16) * FF + col0; f32x4 v[2];
#pragma unroll
                for (int n = 0; n < 2; ++n) { const f32x4 gt = acc[ai][0][m][n], up = acc[ai][1][m][n];
#pragma unroll
                    for (int i = 0; i < 4; ++i) v[n][i] = gt[i] * __builtin_amdgcn_rcpf(1.f + __builtin_amdgcn_exp2f(-1.4426950408889634f * gt[i])) * up[i]; }
                u32x4 w; w.x = cvt_pk(v[0][0], v[0][1]); w.y = cvt_pk(v[0][2], v[0][3]); w.z = cvt_pk(v[1][0], v[1][1]); w.w = cvt_pk(v[1][2], v[1][3]); *(u32x4*)rowp = w; }
    }
};
}

constexpr int AK_BYTES = 64 * KP * 2  , AV_PITCH = 136, AV_BYTES = 128 * AV_PITCH  ;
__device__ __forceinline__ void attn_unit(LAS unsigned char* lds, int b, int h, int q0, int kbeg, int ntiles, const bf16_t* Q, const bf16_t* K, const bf16_t* Vt, bf16_t* cat) {
    int tid = threadIdx.x; asm volatile("" : "+v"(tid));
    const int lane = tid & 63, r32 = lane & 31, hi = lane >> 5; const int wid = __builtin_amdgcn_readfirstlane(tid >> 6);
    const char* Kg = (const char*)(K + ((size_t)(b * 4 + h) * NT + kbeg) * KP);
    const bf16_t* Vg = Vt + (size_t)(b * 4 + h) * 128 * NT + kbeg;
    bf16x8 qf[12];
    { const bf16_t* Qg = Q + ((size_t)(b * 4 + h) * NT + q0 + wid * 32 + r32) * 192 + hi * 8;
#pragma unroll
      for (int ds = 0; ds < 12; ++ds) qf[ds] = *(const bf16x8*)(Qg + ds * 16); }
    f32x16 o[4];
#pragma unroll
    for (int d = 0; d < 4; ++d)
#pragma unroll
        for (int r = 0; r < 16; ++r) o[d][r] = 0.f;
    float mrun = -1e30f, lrun = 0.f;
    u32x4 vr[2];
    const int vd0 = tid >> 3, vpart = tid & 7;
#define ALOAD(kt) do { const char* ks_ = Kg + (size_t)(kt) * AK_BYTES + tid * 16; \
        kr[0] = *(const u32x4*)(ks_); kr[1] = *(const u32x4*)(ks_ + 8192); kr[2] = *(const u32x4*)(ks_ + 16384); if (tid < 64) kr[3] = *(const u32x4*)(ks_ + 24576); \
        vr[0] = *(const u32x4*)(Vg + (size_t)vd0 * NT + (kt) * 64 + vpart * 8); vr[1] = *(const u32x4*)(Vg + (size_t)(vd0 + 64) * NT + (kt) * 64 + vpart * 8); } while (0)
#define ASTORE(buf) do { LAS unsigned char* kd_ = lds + (buf) * AK_BYTES + tid * 16; \
        *(LAS u32x4*)(kd_) = kr[0]; *(LAS u32x4*)(kd_ + 8192) = kr[1]; *(LAS u32x4*)(kd_ + 16384) = kr[2]; if (tid < 64) *(LAS u32x4*)(kd_ + 24576) = kr[3]; \
        LAS unsigned char* vd_ = lds + 2 * AK_BYTES + (buf) * AV_BYTES + vd0 * AV_PITCH + vpart * 16; \
        *(LAS u32x2*)(vd_) = (u32x2){vr[0].x, vr[0].y}; *(LAS u32x2*)(vd_ + 8) = (u32x2){vr[0].z, vr[0].w}; \
        *(LAS u32x2*)(vd_ + 64 * AV_PITCH) = (u32x2){vr[1].x, vr[1].y}; *(LAS u32x2*)(vd_ + 64 * AV_PITCH + 8) = (u32x2){vr[1].z, vr[1].w}; } while (0)
#define ALOADK(kt, buf) do { const char* ks_ = Kg + (size_t)(kt) * AK_BYTES + lane * 16; LAS unsigned char* kd_ = lds + (buf) * AK_BYTES; \
        _Pragma("unroll") for (int pj = 0; pj < 3; ++pj) __builtin_amdgcn_global_load_lds((const unsigned*)(ks_ + (wid + 8 * pj) * 1024), (LAS unsigned*)(kd_ + (wid + 8 * pj) * 1024), 16, 0, 0); \
        if (wid == 0) __builtin_amdgcn_global_load_lds((const unsigned*)(ks_ + 24 * 1024), (LAS unsigned*)(kd_ + 24 * 1024), 16, 0, 0); } while (0)
#define ALOADV(kt) do { vr[0] = *(const u32x4*)(Vg + (size_t)vd0 * NT + (kt) * 64 + vpart * 8); vr[1] = *(const u32x4*)(Vg + (size_t)(vd0 + 64) * NT + (kt) * 64 + vpart * 8); } while (0)
#define ASTOREV(buf) do { LAS unsigned char* vd_ = lds + 2 * AK_BYTES + (buf) * AV_BYTES + vd0 * AV_PITCH + vpart * 16; \
        *(LAS u32x2*)(vd_) = (u32x2){vr[0].x, vr[0].y}; *(LAS u32x2*)(vd_ + 8) = (u32x2){vr[0].z, vr[0].w}; \
        *(LAS u32x2*)(vd_ + 64 * AV_PITCH) = (u32x2){vr[1].x, vr[1].y}; *(LAS u32x2*)(vd_ + 64 * AV_PITCH + 8) = (u32x2){vr[1].z, vr[1].w}; } while (0)
    ALOADK(0, 0); ALOADV(0); ASTOREV(0);
    if (ntiles > 1) ALOADK(1, 1);
    asm volatile("s_waitcnt vmcnt(0)" ::: "memory");
    __syncthreads();
    f32x16 pc0, pc1;
    { const LAS unsigned char* kb = lds + r32 * (KP * 2) + hi * 16;
#pragma unroll
      for (int r = 0; r < 16; ++r) { pc0[r] = 0.f; pc1[r] = 0.f; }
#pragma unroll
      for (int ds = 0; ds < 12; ++ds) {
          const bf16x8 k0 = *(const LAS bf16x8*)(kb + ds * 32), k1 = *(const LAS bf16x8*)(kb + 32 * (KP * 2) + ds * 32);
          pc0 = __builtin_amdgcn_mfma_f32_32x32x16_bf16(k0, qf[ds], pc0, 0, 0, 0);
          pc1 = __builtin_amdgcn_mfma_f32_32x32x16_bf16(k1, qf[ds], pc1, 0, 0, 0); } }
    float mxc;
    { float mx = fmaxf(pc0[0], pc1[0]);
#pragma unroll
      for (int r = 1; r < 16; ++r) mx = fmaxf(mx, fmaxf(pc0[r], pc1[r]));
      mxc = fmaxf(mx, __shfl_xor(mx, 32)); }
    __syncthreads();
    for (int kt = 0; kt < ntiles; ++kt) {
        const int buf = kt & 1;
        if (kt + 2 < ntiles) ALOADK(kt + 2, buf);
        if (kt + 1 < ntiles) ALOADV(kt + 1);
        if (__any(mxc > mrun + 8.f)) {
            const float mnew = fmaxf(mrun, mxc), alpha = __builtin_amdgcn_exp2f(mrun - mnew);
            mrun = mnew; lrun *= alpha;
#pragma unroll
            for (int d = 0; d < 4; ++d)
#pragma unroll
                for (int r = 0; r < 16; ++r) o[d][r] *= alpha;
        }
        const LAS unsigned char* kb = lds + (buf ^ 1) * AK_BYTES + r32 * (KP * 2) + hi * 16;
        f32x16 pn0, pn1;
#pragma unroll
        for (int r = 0; r < 16; ++r) { pn0[r] = 0.f; pn1[r] = 0.f; }
        float ps = 0.f; u32x4 pw[4];
        bf16x8 ka = *(const LAS bf16x8*)(kb), kbb = *(const LAS bf16x8*)(kb + 32 * (KP * 2));
#pragma unroll
        for (int ds = 0; ds < 12; ++ds) {
            bf16x8 na = ka, nb = kbb;
            if (ds < 11) { na = *(const LAS bf16x8*)(kb + (ds + 1) * 32); nb = *(const LAS bf16x8*)(kb + 32 * (KP * 2) + (ds + 1) * 32); }
            pn0 = __builtin_amdgcn_mfma_f32_32x32x16_bf16(ka, qf[ds], pn0, 0, 0, 0);
            pn1 = __builtin_amdgcn_mfma_f32_32x32x16_bf16(kbb, qf[ds], pn1, 0, 0, 0);
            if (ds < 8) {
                float e[4];
#pragma unroll
                for (int j = 0; j < 4; ++j) { const float v = ds < 4 ? pc0[4 * ds + j] : pc1[4 * (ds - 4) + j]; e[j] = __builtin_amdgcn_exp2f(v - mrun); }
                ps += (e[0] + e[1]) + (e[2] + e[3]);
                const unsigned w0 = cvt_pk(e[0], e[1]), w1 = cvt_pk(e[2], e[3]);
                if ((ds & 1) == 0) { pw[ds >> 1].x = w0; pw[ds >> 1].y = w1; } else { pw[ds >> 1].z = w0; pw[ds >> 1].w = w1; }
            }
            ka = na; kbb = nb;
            __builtin_amdgcn_sched_barrier(0);
        }
        lrun += ps;
        const LAS unsigned char* vb = lds + 2 * AK_BYTES + buf * AV_BYTES + r32 * AV_PITCH + hi * 8;
#pragma unroll
        for (int d = 0; d < 4; ++d)
#pragma unroll
            for (int ks = 0; ks < 4; ++ks) {
                const s16x4 lo = *(const LAS s16x4*)(vb + d * 32 * AV_PITCH + ks * 32), hh = *(const LAS s16x4*)(vb + d * 32 * AV_PITCH + ks * 32 + 16);
                const bf16x8 vf = (bf16x8){lo[0], lo[1], lo[2], lo[3], hh[0], hh[1], hh[2], hh[3]};
                o[d] = __builtin_amdgcn_mfma_f32_32x32x16_bf16(vf, __builtin_bit_cast(bf16x8, pw[ks]), o[d], 0, 0, 0);
            }
        { float mx = fmaxf(pn0[0], pn1[0]);
#pragma unroll
          for (int r = 1; r < 16; ++r) mx = fmaxf(mx, fmaxf(pn0[r], pn1[r]));
          mxc = fmaxf(mx, __shfl_xor(mx, 32)); }
        if (kt + 1 < ntiles) ASTOREV(buf ^ 1);
        asm volatile("s_waitcnt vmcnt(0)" ::: "memory");
        __syncthreads();
        pc0 = pn0; pc1 = pn1;
    }
#undef ALOADK
#undef ALOADV
#undef ASTOREV
#undef ALOAD
#undef ASTORE
    const float inv = 1.f / (lrun + __shfl_xor(lrun, 32));
    bf16_t* op = cat + ((size_t)b * NT + q0 + wid * 32 + r32) * DM + h * 128 + 4 * hi;
#pragma unroll
    for (int d = 0; d < 4; ++d)
#pragma unroll
        for (int gq = 0; gq < 4; ++gq) { u32x2 w; w.x = cvt_pk(o[d][4 * gq] * inv, o[d][4 * gq + 1] * inv); w.y = cvt_pk(o[d][4 * gq + 2] * inv, o[d][4 * gq + 3] * inv); *(u32x2*)(op + d * 32 + gq * 8) = w; }
}

__device__ __forceinline__ int scan_row(int b, int dir, int s) { if (s < TC) return b * NT + TL + (dir ? TC - 1 - s : s); const int li = s - TC; return b * NT + (dir ? TL - 1 - li : li); }
constexpr int S_QT = 0, S_QH = 17408, S_KD = 34816, S_KX = 52224, S_K4T = 78336, S_VT = 96768, S_ST = 105984, S_P = 123392, S_TOT = 132608, S_TS = 133120, S_LB = 137216;
__device__ __forceinline__ void scan_job(LAS unsigned char* lds, int b, int h, int dir, int layer, const bf16_t* P, const float* lbp, bf16_t* xc, bf16_t* ob) {
    int tid = threadIdx.x; asm volatile("" : "+v"(tid));
    const int lane = tid & 63; const int wid = __builtin_amdgcn_readfirstlane(tid >> 6);
    const int kp = tid & 63, g = wid, si = g >> 1;
    const int l15 = lane & 15, lq = lane >> 4;
    LAS float* TOT = (LAS float*)(lds + S_TOT); LAS float* TS = (LAS float*)(lds + S_TS); LAS float* LB = (LAS float*)(lds + S_LB);
    __syncthreads();
    if (tid < 128) { float lb = 0.f; if (layer == 1) { const float a0 = lbp[(0 * 2 + dir) * 512 + h * 128 + tid], a1 = lbp[(1 * 2 + dir) * 512 + h * 128 + tid]; lb = 1.f / (1.f + __expf(a0 - a1)); } LB[tid] = lb; }
    for (int i = tid; i < (17408 + 9216) / 16; i += 512) { const int off = i < 1088 ? S_ST + i * 16 : S_P + (i - 1088) * 16; *(LAS u32x4*)(lds + off) = (u32x4){0u, 0u, 0u, 0u}; }
    const int zoff = dir ? O_HFB : O_HFF; const long rstep = dir ? -(long)INP : (long)INP;
    f32x4 Sacc[4];
#pragma unroll
    for (int j = 0; j < 4; ++j) Sacc[j] = (f32x4){0.f, 0.f, 0.f, 0.f};
    unsigned q2[8], z2[8]; u32x2 vra, vrb;
#define CLOAD(ch) do { const bf16_t* pr_ = P + (size_t)scan_row(b, dir, (ch) * 64 + g * 8) * INP + h * 128 + 2 * kp; \
        _Pragma("unroll") for (int tt = 0; tt < 8; ++tt) { q2[tt] = *(const unsigned*)(pr_ + O_HQ); z2[tt] = *(const unsigned*)(pr_ + zoff); pr_ += rstep; } \
        vra = *(const u32x2*)(P + (size_t)scan_row(b, dir, (ch) * 64 + 2 * (tid >> 4)) * INP + O_HI + h * 64 + (tid & 15) * 4); \
        vrb = *(const u32x2*)(P + (size_t)scan_row(b, dir, (ch) * 64 + 2 * (tid >> 4) + 1) * INP + O_HI + h * 64 + (tid & 15) * 4); } while (0)
    CLOAD(0);
    __syncthreads();
    const float lb0 = LB[2 * kp], lb1 = LB[2 * kp + 1];
    for (int ch = 0; ch < NT / 64; ++ch) {
        float qv[2][8], kk[2][8], pf[2][8];
#pragma unroll
        for (int c = 0; c < 2; ++c) { float run = 1.f; const float lb = c ? lb1 : lb0;
#pragma unroll
            for (int tt = 0; tt < 8; ++tt) { const float xq = c ? bfhi(q2[tt]) : bflo(q2[tt]), xz = c ? bfhi(z2[tt]) : bflo(z2[tt]);
                qv[c][tt] = xq * __builtin_amdgcn_rcpf(1.f + __builtin_amdgcn_exp2f(-1.4426950408889634f * xq));
                const float f = lb + (1.f - lb) * __builtin_amdgcn_rcpf(1.f + __builtin_amdgcn_exp2f(-1.4426950408889634f * xz));
                kk[c][tt] = 1.f - f; run = fmaxf(run * f, 7.888609052210118e-31f); pf[c][tt] = run; }
            TS[g * 128 + 2 * kp + c] = __builtin_amdgcn_logf(run); }
        { const int s2 = 2 * (tid >> 4), v4 = (tid & 15) * 4; LAS unsigned* vt = (LAS unsigned*)(lds + S_VT + v4 * 144 + s2 * 2);
          vt[0] = (vra.x & 0xffffu) | (vrb.x << 16); vt[36] = (vra.x >> 16) | (vrb.x & 0xffff0000u); vt[72] = (vra.y & 0xffffu) | (vrb.y << 16); vt[108] = (vra.y >> 16) | (vrb.y & 0xffff0000u); }
        __syncthreads();
        if (ch + 1 < NT / 64) CLOAD(ch + 1);
        { float qa[2][8], ka[2][8], eBv[2], e1v[2], e2v[2], e3v[2], eTv[2];
#pragma unroll
          for (int c = 0; c < 2; ++c) { const int k = 2 * kp + c; float Bg[9]; Bg[0] = 0.f;
#pragma unroll
              for (int j = 0; j < 8; ++j) Bg[j + 1] = Bg[j] + TS[j * 128 + k];
              const float Bi = si == 0 ? Bg[0] : (si == 1 ? Bg[2] : (si == 2 ? Bg[4] : Bg[6]));
              const float Bgg = (g & 1) ? (si == 0 ? Bg[1] : (si == 1 ? Bg[3] : (si == 2 ? Bg[5] : Bg[7]))) : Bi;
              const float eoc = __builtin_amdgcn_exp2f(Bgg - Bi);
              eBv[c] = __builtin_amdgcn_exp2f(Bi); e1v[c] = __builtin_amdgcn_exp2f(Bg[2] - Bi); e2v[c] = __builtin_amdgcn_exp2f(Bg[4] - Bi); e3v[c] = __builtin_amdgcn_exp2f(Bg[6] - Bi); eTv[c] = __builtin_amdgcn_exp2f(Bg[8] - Bi);
              if (g == 0) TOT[k] = __builtin_amdgcn_exp2f(Bg[8]);
#pragma unroll
              for (int tt = 0; tt < 8; ++tt) { const float pfu = fmaxf(pf[c][tt] * eoc, 7.888609052210118e-31f); qa[c][tt] = qv[c][tt] * pfu; ka[c][tt] = kk[c][tt] * __builtin_amdgcn_rcpf(pfu); } }
          LAS unsigned* qt = (LAS unsigned*)(lds + S_QT + (8 * g) * 272 + 4 * kp); LAS unsigned* qh = (LAS unsigned*)(lds + S_QH + (8 * g) * 272 + 4 * kp);
          LAS unsigned* kd = (LAS unsigned*)(lds + S_KD + (8 * g) * 272 + 4 * kp); LAS unsigned* kx = (LAS unsigned*)(lds + S_KX + (8 * g) * 272 + 4 * kp);
          unsigned k4[2][4];
#pragma unroll
          for (int tt = 0; tt < 8; ++tt) {
              qt[tt * 68] = cvt_pk(qa[0][tt], qa[1][tt]); qh[tt * 68] = cvt_pk(qa[0][tt] * eBv[0], qa[1][tt] * eBv[1]); kd[tt * 68] = cvt_pk(ka[0][tt], ka[1][tt]);
              if (si < 1) kx[tt * 68] = cvt_pk(ka[0][tt] * e1v[0], ka[1][tt] * e1v[1]);
              if (si < 2) kx[(16 + tt) * 68] = cvt_pk(ka[0][tt] * e2v[0], ka[1][tt] * e2v[1]);
              if (si < 3) kx[(48 + tt) * 68] = cvt_pk(ka[0][tt] * e3v[0], ka[1][tt] * e3v[1]); }
#pragma unroll
          for (int c = 0; c < 2; ++c) {
#pragma unroll
              for (int t2 = 0; t2 < 4; ++t2) k4[c][t2] = cvt_pk(ka[c][2 * t2] * eTv[c], ka[c][2 * t2 + 1] * eTv[c]);
              *(LAS u32x4*)(lds + S_K4T + (2 * kp + c) * 144 + g * 16) = (u32x4){k4[c][0], k4[c][1], k4[c][2], k4[c][3]}; } }
        __syncthreads();
        for (int bl = wid; bl < 10; bl += 8) { const int bi = bl >= 6 ? 3 : (bl >= 3 ? 2 : (bl >= 1 ? 1 : 0)), bj = bl - (bi * (bi + 1)) / 2;
            const LAS unsigned char* ap = lds + S_QT + (16 * bi + l15) * 272 + lq * 16;
            const int krow = bi == bj ? 16 * bi : (bi == 1 ? 0 : (bi == 2 ? 16 : 48)) + 16 * bj;
            const LAS unsigned char* bp = lds + (bi == bj ? S_KD : S_KX) + (krow + l15) * 272 + lq * 16;
            f32x4 sc = (f32x4){0.f, 0.f, 0.f, 0.f};
#pragma unroll
            for (int ks = 0; ks < 4; ++ks) sc = __builtin_amdgcn_mfma_f32_16x16x32_bf16(*(const LAS bf16x8*)(ap + ks * 64), *(const LAS bf16x8*)(bp + ks * 64), sc, 0, 0, 0);
            LAS bf16_t* pp = (LAS bf16_t*)(lds + S_P) + (16 * bi + 4 * lq) * 72 + 16 * bj + l15;
#pragma unroll
            for (int r = 0; r < 4; ++r) { float v = sc[r]; if (bi == bj && l15 > 4 * lq + r) v = 0.f; pp[r * 72] = (bf16_t)f2bf(v); } }
        __syncthreads();
        { const int ti = wid >> 1, vj0 = 2 * (wid & 1);
          const LAS unsigned char* pa = lds + S_P + (16 * ti + l15) * 144 + lq * 16; const LAS unsigned char* qa = lds + S_QH + (16 * ti + l15) * 272 + lq * 16;
          const bf16x8 a0 = *(const LAS bf16x8*)(pa), a1 = *(const LAS bf16x8*)(pa + 64);
          const bf16x8 q0 = *(const LAS bf16x8*)(qa), q1 = *(const LAS bf16x8*)(qa + 64), q2 = *(const LAS bf16x8*)(qa + 128), q3 = *(const LAS bf16x8*)(qa + 192);
          const size_t row0 = (size_t)scan_row(b, dir, ch * 64 + 16 * ti + 4 * lq);
#pragma unroll
          for (int vv = 0; vv < 2; ++vv) { const int vj = vj0 + vv;
              const LAS unsigned char* vb = lds + S_VT + (16 * vj + l15) * 144 + lq * 16; const LAS unsigned char* sb = lds + S_ST + (16 * vj + l15) * 272 + lq * 16;
              f32x4 o = (f32x4){0.f, 0.f, 0.f, 0.f};
              o = __builtin_amdgcn_mfma_f32_16x16x32_bf16(a0, *(const LAS bf16x8*)(vb), o, 0, 0, 0);
              o = __builtin_amdgcn_mfma_f32_16x16x32_bf16(a1, *(const LAS bf16x8*)(vb + 64), o, 0, 0, 0);
              o = __builtin_amdgcn_mfma_f32_16x16x32_bf16(q0, *(const LAS bf16x8*)(sb), o, 0, 0, 0);
              o = __builtin_amdgcn_mfma_f32_16x16x32_bf16(q1, *(const LAS bf16x8*)(sb + 64), o, 0, 0, 0);
              o = __builtin_amdgcn_mfma_f32_16x16x32_bf16(q2, *(const LAS bf16x8*)(sb + 128), o, 0, 0, 0);
              o = __builtin_amdgcn_mfma_f32_16x16x32_bf16(q3, *(const LAS bf16x8*)(sb + 192), o, 0, 0, 0);
              const int col = h * 64 + 16 * vj + l15;
#pragma unroll
              for (int r = 0; r < 4; ++r) { const size_t row = dir ? row0 - r : row0 + r;
                  if (dir == 0) xc[row * DM + 512 + col] = (bf16_t)f2bf(o[r]); else ob[row * 256 + col] = (bf16_t)f2bf(o[r]); } } }
        { const f32x4 dec = *(const LAS f32x4*)(TOT + 16 * wid + 4 * lq);
          const LAS unsigned char* ka = lds + S_K4T + (16 * wid + l15) * 144 + lq * 16; const bf16x8 k0 = *(const LAS bf16x8*)(ka), k1 = *(const LAS bf16x8*)(ka + 64);
#pragma unroll
          for (int vj = 0; vj < 4; ++vj) { const LAS unsigned char* vb = lds + S_VT + (16 * vj + l15) * 144 + lq * 16;
              f32x4 a = Sacc[vj] * dec;
              a = __builtin_amdgcn_mfma_f32_16x16x32_bf16(k0, *(const LAS bf16x8*)(vb), a, 0, 0, 0);
              a = __builtin_amdgcn_mfma_f32_16x16x32_bf16(k1, *(const LAS bf16x8*)(vb + 64), a, 0, 0, 0);
              Sacc[vj] = a; } }
        __syncthreads();
#pragma unroll
        for (int vj = 0; vj < 4; ++vj) { u32x2 w; w.x = cvt_pk(Sacc[vj][0], Sacc[vj][1]); w.y = cvt_pk(Sacc[vj][2], Sacc[vj][3]);
            *(LAS u32x2*)(lds + S_ST + (16 * vj + l15) * 272 + (16 * wid + 4 * lq) * 2) = w; }
    }
#undef CLOAD
    __syncthreads();
}


#define XB_TMO      128
#define XB_XCNT(j)  (256  + 64 * (j))
#define XB_XSUB(j)  (1280 + 64 * (j))
#define XB_XGEN(j)  (2304 + 64 * (j))
#define XB_TOP      3328
#define XB_TOPGEN   3392
#define XCD_BAR_WORDS 3456
#define XB_SPIN_CAP (1u << 18)
__device__ __forceinline__ unsigned xb_ld(unsigned* p)              { return __hip_atomic_load(p, __ATOMIC_RELAXED, __HIP_MEMORY_SCOPE_AGENT); }
__device__ __forceinline__ unsigned xb_add(unsigned* p, unsigned v) { return __hip_atomic_fetch_add(p, v, __ATOMIC_RELAXED, __HIP_MEMORY_SCOPE_AGENT); }
__device__ __forceinline__ unsigned xb_xcc_id() { return (unsigned)__builtin_amdgcn_s_getreg((3 << 11) | 20) & 0xFu; }
#define XB_SPIN(cond, bar) do { unsigned _sp = 0; while (cond) { __builtin_amdgcn_s_sleep(1); \
    if ((++_sp & 255u) == 0u) { if (xb_ld(&(bar)[XB_TMO])) break; if (_sp > XB_SPIN_CAP) { atomicAdd(&(bar)[XB_TMO], 1u); break; } } } } while (0)
struct XcdBarrier { unsigned* bar; unsigned x; volatile LAS unsigned* st; };
__device__ __forceinline__ XcdBarrier xcd_barrier_post(unsigned* bar, volatile LAS unsigned* st) {
    XcdBarrier b; b.bar = bar; b.x = xb_xcc_id(); b.st = st;
    if (threadIdx.x == 0) (void)xb_add(&bar[XB_XCNT(b.x)], 1u);
    return b;
}
__device__ __forceinline__ void xcd_barrier_complete(unsigned* bar, unsigned x, unsigned& nloc, unsigned& nx) {
    const unsigned G = gridDim.x * gridDim.y * gridDim.z;
    unsigned sum, cnt, mine, sp = 0u;
    for (;;) {
        sum = 0u; cnt = 0u; mine = 0u;
#pragma unroll
        for (unsigned j = 0; j < 16; ++j) { const unsigned c = xb_ld(&bar[XB_XCNT(j)]); sum += c; cnt += (c > 0u) ? 1u : 0u; mine = (j == x) ? c : mine; }
        if (sum == G) break;
        __builtin_amdgcn_s_sleep(1);
        if ((++sp & 255u) == 0u) { if (xb_ld(&bar[XB_TMO])) break; if (sp > XB_SPIN_CAP) { atomicAdd(&bar[XB_TMO], 1u); break; } }
    }
    nloc = mine > 0u ? mine : 1u; nx = cnt > 0u ? cnt : 1u;
}
__device__ __forceinline__ void xcd_barrier(const XcdBarrier& b) {
    asm volatile("s_waitcnt vmcnt(0)" ::: "memory");
    __syncthreads();
    if (threadIdx.x == 0) {
        unsigned* bar = b.bar;
        __builtin_amdgcn_s_waitcnt(0);
        unsigned nloc = b.st[0], nx = b.st[1];
        if (nloc == 0u) { xcd_barrier_complete(bar, b.x, nloc, nx); b.st[0] = nloc; b.st[1] = nx; }
        const unsigned old = xb_add(&bar[XB_XSUB(b.x)], 1u);
        const unsigned gen = old / nloc;
        if (old + 1u == (gen + 1u) * nloc) {
            __builtin_amdgcn_fence(__ATOMIC_RELEASE, "agent");
            asm volatile("s_waitcnt vmcnt(0)" ::: "memory");
            const unsigned og = xb_add(&bar[XB_TOP], 1u);
            const unsigned tg = og / nx;
            if (og + 1u == (tg + 1u) * nx) xb_add(&bar[XB_TOPGEN], 1u);
            else XB_SPIN(xb_ld(&bar[XB_TOPGEN]) == tg, bar);
            __builtin_amdgcn_fence(__ATOMIC_ACQUIRE, "agent");
            xb_add(&bar[XB_XGEN(b.x)], 1u);
            asm volatile("s_waitcnt vmcnt(0)" ::: "memory");
        } else {
            XB_SPIN(xb_ld(&bar[XB_XGEN(b.x)]) == gen, bar);
            __builtin_amdgcn_fence(__ATOMIC_ACQUIRE, "agent");
            asm volatile("s_waitcnt vmcnt(0)" ::: "memory");
        }
    }
    __syncthreads();
}
constexpr int LDS_BARST = 147456 - 64;

struct Args { const float* in[20]; float* out; unsigned char* ws; int ph_lo, ph_hi; };

__device__ __forceinline__ void transpose_item(const float* W, int ldw, int k0, int n0, bf16_t* WT, int ldt, int drow0, LAS float* scr, int lane) {
#pragma unroll 16
    for (int i = 0; i < 32; ++i) { const int kk = 2 * i + (lane >> 5); scr[kk * 33 + (lane & 31)] = W[(size_t)(k0 + kk) * ldw + n0 + (lane & 31)]; }
    asm volatile("s_waitcnt lgkmcnt(0)" ::: "memory");
    const int c = lane & 7;
#pragma unroll
    for (int j = 0; j < 4; ++j) { const int n = (lane >> 3) + 8 * j; const LAS float* s = scr + (8 * c) * 33 + n;
        u32x4 o; o.x = f2bf(s[0]) | (f2bf(s[33]) << 16); o.y = f2bf(s[66]) | (f2bf(s[99]) << 16); o.z = f2bf(s[132]) | (f2bf(s[165]) << 16); o.w = f2bf(s[198]) | (f2bf(s[231]) << 16);
        *(u32x4*)(WT + (size_t)(drow0 + n) * ldt + k0 + 8 * c) = o; }
    asm volatile("s_waitcnt lgkmcnt(0)" ::: "memory");
}

template <int PH> __device__ __forceinline__ void phase_body(const Args& args, LAS unsigned char* lds) {
    const int G = gridDim.x, bx = blockIdx.x;
    const int vcu = (G % 8 == 0) ? (bx % 8) * (G / 8) + bx / 8 : bx;
    unsigned char* ws = args.ws;
    const float* x_in = args.in[0]; const float* c_in = args.in[1]; const float* ctx_in = args.in[2]; const float* cctx = args.in[3];
    const float* w_mod = args.in[4]; const float* b_mod = args.in[5]; const float* n1g = args.in[6]; const float* n2g = args.in[7]; const float* w_in = args.in[8];
    const float* qng = args.in[9]; const float* w_uq = args.in[10]; const float* kvng = args.in[11]; const float* w_ukv = args.in[12]; const float* lbp = args.in[13];
    const float* hgg = args.in[14]; const float* w_fou = args.in[15]; const float* w_out = args.in[16]; const float* w_gu = args.in[17]; const float* w_dn = args.in[18]; const float* fng = args.in[19];
    float* out = args.out;
    bf16_t* WIN = (bf16_t*)(ws + W_WIN); bf16_t* WGU = (bf16_t*)(ws + W_WGU); bf16_t* WDN = (bf16_t*)(ws + W_WDN); bf16_t* WOUT = (bf16_t*)(ws + W_WOUT);
    bf16_t* WS = (bf16_t*)(ws + W_WS);
    bf16_t* DMAT = (bf16_t*)(ws + W_DM); bf16_t* DCM = (bf16_t*)(ws + W_DC); float* COST = (float*)(ws + W_COS); float* SINT = (float*)(ws + W_SIN);
    float* MOD = (float*)(ws + W_MOD); float* STAT = (float*)(ws + W_STAT); bf16_t* OB = (bf16_t*)(ws + W_OB); bf16_t* ZC = (bf16_t*)(ws + W_ZC); bf16_t* ZCC = (bf16_t*)(ws + W_ZCC);
    bf16_t* VT = (bf16_t*)(ws + W_VT); bf16_t* KB = (bf16_t*)(ws + W_K); bf16_t* QB = (bf16_t*)(ws + W_Q); bf16_t* XR = (bf16_t*)args.out;
    bf16_t* XC = (bf16_t*)(ws + W_XC); bf16_t* PB = (bf16_t*)(ws + W_P);

        int tid = threadIdx.x; asm volatile("" : "+v"(tid));
        const int lane = tid & 63; const int wave = __builtin_amdgcn_readfirstlane(tid >> 6);
        const int gw = bx * 8 + wave, NGW = G * 8; const int gt = bx * 512 + tid, NGT = G * 512;
        if constexpr (PH == 0) { if (EN(0)) REP(8) {
            LAS float* scr = (LAS float*)(lds + wave * 8704);
            { constexpr int I_IN = 16 * 86, I_GU = 16 * 176, I_DN = 44 * 32, I_OUT = 12 * 32, PERL = I_IN + I_GU + I_DN + I_OUT;
              for (int it = gw; it < 2 * PERL; it += NGW) { const int l = it / PERL; int r = it - l * PERL;
                  if (r < I_IN) { const int kb = r / 86, nb = r % 86; transpose_item(w_in + (size_t)l * DM * INW, INW, kb * 64, nb * 32, WIN + (size_t)l * INP * DM, DM, nb * 32, scr, lane); continue; } r -= I_IN;
                  if (r < I_GU) { const int kb = r / 176, nb = r % 176; const int n0 = nb * 32, half = n0 >= FF ? 1 : 0, j0 = n0 - half * FF;
                      transpose_item(w_gu + (size_t)l * DM * 5632, 5632, kb * 64, n0, WGU + (size_t)l * 5632 * DM, DM, 256 * (j0 / 128) + half * 128 + (j0 % 128), scr, lane); continue; } r -= I_GU;
                  if (r < I_DN) { const int kb = r / 32, nb = r % 32; transpose_item(w_dn + (size_t)l * FF * DM, DM, kb * 64, nb * 32, WDN + (size_t)l * DM * FF, FF, nb * 32, scr, lane); continue; } r -= I_DN;
                  { const int kb = r / 32, nb = r % 32; transpose_item(w_out + (size_t)l * DM * DM, DM, kb * 64, nb * 32, WOUT + (size_t)l * DM * DM, DM, nb * 32, scr, lane); } } }
            for (int i = gt; i < 2 * 64 * DM / 8; i += NGT) { const int l = i / (64 * DM / 8), r = i % (64 * DM / 8); *(u32x4*)(WIN + (size_t)l * INP * DM + (size_t)INW * DM + r * 8) = (u32x4){0u, 0u, 0u, 0u}; }
            for (int i = gt; i < 2 * 256 * 768; i += NGT) { const int l = i / (256 * 768), r = i % (256 * 768), k = r / 768, n = r % 768;
                WS[(size_t)n * INP + l * 1024 + k] = (bf16_t)f2bf(w_uq[(size_t)l * 256 * 768 + k * 768 + n] * qng[l * 256 + k]);
                const int h = n / 192, d = n % 192; float v;
                if (d < 128) v = k < 128 ? w_ukv[(size_t)l * 128 * 1024 + k * 1024 + h * 256 + d] * kvng[l * 128 + k] : 0.f; else v = (k == d) ? 1.f : 0.f;
                WS[(size_t)n * INP + l * 1024 + 256 + k] = (bf16_t)f2bf(v); }
            for (int i = gt; i < 2 * 256 * 512; i += NGT) { const int l = i / (256 * 512), r = i % (256 * 512), k = r / 512, n = r % 512; const int h = n / 128, d = n % 128;
                const float v = k < 128 ? w_ukv[(size_t)l * 128 * 1024 + k * 1024 + h * 256 + 128 + d] * kvng[l * 128 + k] : 0.f;
                WS[(size_t)n * INP + l * 1024 + 512 + k] = (bf16_t)f2bf(v); }
            for (int i = gt; i < 2 * 256 * 1024; i += NGT) { const int l = i / (256 * 1024), r = i % (256 * 1024), kp = r / 1024, n = r % 1024;
                const float* wf = w_fou + (size_t)l * 256 * 256 + kp * 256; const float* wo = w_out + (size_t)l * DM * DM + (size_t)768 * DM + n; float s = 0.f;
                for (int j = 0; j < 256; ++j) s = fmaf(wf[j], wo[(size_t)j * DM], s);
                WOUT[(size_t)l * DM * DM + (size_t)n * DM + 768 + kp] = (bf16_t)f2bf(s); }
            for (int i = gt; i < 512 * 256; i += NGT) { const int m = i / 256, k = i % 256, np = m >> 1, which = m & 1; float v = 0.f;
                if ((np >> 6) == (k >> 6)) { const int mm = ((np & 63) * (k & 63)) & 63; v = (which ? sinpif((float)mm * (1.f / 32.f)) : cospif((float)mm * (1.f / 32.f))) * 0.125f; }
                WS[(size_t)m * INP + 2048 + k] = (bf16_t)f2bf(v); }
            for (int i = gt; i < TL * TL; i += NGT) { const int tp = i / TL, t = i % TL; const float a = (float)((tp * t) & (TL - 1)) * (1.f / 1024.f);
                DMAT[(size_t)tp * 4096 + t] = (bf16_t)f2bf(cospif(a) * 0.022097086912079608f); DMAT[(size_t)tp * 4096 + TL + t] = (bf16_t)f2bf(-sinpif(a) * 0.022097086912079608f); }
            for (int i = gt; i < TC * TC; i += NGT) { const int tp = i / TC, t = i % TC; const float a = (float)((tp * t) & (TC - 1)) * (1.f / 128.f);
                DCM[tp * 512 + t] = (bf16_t)f2bf(cospif(a) * 0.0625f); DCM[tp * 512 + TC + t] = (bf16_t)f2bf(-sinpif(a) * 0.0625f); }
            for (int i = gt; i < TL * 32; i += NGT) { const int t = i / 32, jj = i % 32, j = jj & 15; const float pos = (float)(jj < 16 ? (t >> 6) : (t & 63));
                const float ang = pos * powf(10000.f, -(float)(2 * j) / 32.f); COST[i] = cosf(ang); SINT[i] = sinf(ang); }
            __syncthreads();
            for (int it = bx; it < 2 * 96; it += G) { const int l = it / 96, n = (it % 96) * 64 + lane; const float* wm = w_mod + (size_t)l * DM * 6144 + n;
                float acc[33];
#pragma unroll
                for (int m = 0; m < 33; ++m) acc[m] = 0.f;
                LAS float* sa = (LAS float*)lds;
#pragma nounroll
                for (int kh = 0; kh < 2; ++kh) {
                    __syncthreads();
#pragma unroll
                    for (int mb_ = 0; mb_ < 2; ++mb_) { float cv[16];
#pragma unroll
                      for (int m = 0; m < 16; ++m) cv[m] = c_in[(mb_ * 16 + m) * DM + kh * 512 + tid];
#pragma unroll
                      for (int m4 = 0; m4 < 4; ++m4) *(LAS f32x4*)(sa + tid * 36 + mb_ * 16 + m4 * 4) = (f32x4){silu_f(cv[m4 * 4]), silu_f(cv[m4 * 4 + 1]), silu_f(cv[m4 * 4 + 2]), silu_f(cv[m4 * 4 + 3])}; }
                    sa[tid * 36 + 32] = silu_f(cctx[kh * 512 + tid]);
                    __syncthreads();
                    for (int kk0 = 0; kk0 < 64; kk0 += 16) { float wv[16];
#pragma unroll
                        for (int u = 0; u < 16; ++u) wv[u] = wm[(size_t)(kh * 512 + wave * 64 + kk0 + u) * 6144];
#pragma unroll
                        for (int u = 0; u < 16; ++u) { const float w = wv[u]; const LAS float* sp = sa + (wave * 64 + kk0 + u) * 36;
#pragma unroll
                            for (int m4 = 0; m4 < 8; ++m4) { const f32x4 s4 = *(const LAS f32x4*)(sp + m4 * 4);
#pragma unroll
                                for (int i = 0; i < 4; ++i) acc[m4 * 4 + i] = fmaf(s4[i], w, acc[m4 * 4 + i]); }
                            acc[32] = fmaf(sp[32], w, acc[32]); } }
                }
                __syncthreads();
                LAS float* red = (LAS float*)lds;
#pragma unroll
                for (int m = 0; m < 33; ++m) red[(wave * 33 + m) * 64 + lane] = acc[m];
                __syncthreads();
                for (int i = tid; i < 33 * 64; i += 512) { const int m = i / 64, nn = i % 64; float s = 0.f;
#pragma unroll
                    for (int w = 0; w < 8; ++w) s += red[(w * 33 + m) * 64 + nn];
                    const int ncol = (it % 96) * 64 + nn; MOD[((size_t)l * 33 + m) * 6144 + ncol] = s + b_mod[l * 6144 + ncol]; }
                __syncthreads();
            }
        } } else if constexpr (PH == NPHASE - 1) { if (EN(9)) {
            for (int R = 4 * gw; R < NB * TL; R += 4 * NGW) { const int b = R / TL, n = R - b * TL; const bf16_t* xs = XC + ((size_t)b * NT + n) * DM + lane * 4; float* xr = out + (size_t)R * DM + lane * 4;
                u32x2 q[4][4]; float rr[4];
#pragma unroll
                for (int rw = 0; rw < 4; ++rw)
#pragma unroll
                    for (int j = 0; j < 4; ++j) q[rw][j] = *(const u32x2*)(xs + (size_t)rw * DM + 256 * j);
#pragma unroll
                for (int rw = 0; rw < 4; ++rw) { float s_ = 0.f;
#pragma unroll
                    for (int j = 0; j < 4; ++j) { const float a0 = bflo(q[rw][j].x), a1 = bfhi(q[rw][j].x), a2 = bflo(q[rw][j].y), a3 = bfhi(q[rw][j].y); s_ += (a0 * a0 + a1 * a1) + (a2 * a2 + a3 * a3); }
                    rr[rw] = rsqrtf(wave_sum(s_) * (1.f / DM) + EPS); }
#pragma unroll
                for (int j = 0; j < 4; ++j) { const f32x4 g4 = *(const f32x4*)(fng + lane * 4 + 256 * j);
#pragma unroll
                    for (int rw = 0; rw < 4; ++rw) { const f32x4 v = (f32x4){bflo(q[rw][j].x), bfhi(q[rw][j].x), bflo(q[rw][j].y), bfhi(q[rw][j].y)};
                        __builtin_nontemporal_store(v * rr[rw] * g4, (f32x4*)(xr + (size_t)rw * DM + 256 * j)); } } }
        } } else {
            constexpr int l = (PH - 1) >> 3, sub = (PH - 1) & 7;
            const float* modl = MOD + (size_t)l * 33 * 6144;
            if ((sub == 0 || sub == 5) && EN(1)) {
                const float* srcL = x_in; const float* srcC = ctx_in;
                const float* gain = (sub == 0 ? n1g : n2g) + l * DM; const int shoff = sub == 0 ? 0 : 3072, scoff = shoff + 1024;
                if (sub == 0 && l == 0) {
                REP(4) for (int R = 4 * gw; R < MR; R += 4 * NGW) { const int b = R / NT, n = R - b * NT; const bool isc = n >= TL;
                    const float* xr = (isc ? srcC + ((size_t)b * TC + n - TL) * DM : srcL + ((size_t)b * TL + n) * DM) + lane * 4; const float* mp = modl + (isc ? 32 : b) * 6144 + lane * 4;
                    f32x4 v[4][4]; float rr[4];
#pragma unroll
                    for (int rw = 0; rw < 4; ++rw)
#pragma unroll
                        for (int j = 0; j < 4; ++j) v[rw][j] = __builtin_nontemporal_load((const f32x4*)(xr + (size_t)rw * DM + 256 * j));
#pragma unroll
                    for (int rw = 0; rw < 4; ++rw) { float s_ = 0.f;
#pragma unroll
                        for (int j = 0; j < 4; ++j) s_ += (v[rw][j][0] * v[rw][j][0] + v[rw][j][1] * v[rw][j][1]) + (v[rw][j][2] * v[rw][j][2] + v[rw][j][3] * v[rw][j][3]);
                        rr[rw] = rsqrtf(wave_sum(s_) * (1.f / DM) + EPS); }
#pragma unroll
                    for (int j = 0; j < 4; ++j) { const f32x4 g4 = *(const f32x4*)(gain + lane * 4 + 256 * j), sc = *(const f32x4*)(mp + scoff + 256 * j) + 1.f, sh = *(const f32x4*)(mp + shoff + 256 * j);
#pragma unroll
                        for (int rw = 0; rw < 4; ++rw) { const f32x4 y = (v[rw][j] * rr[rw] * g4) * sc + sh; u32x2 w; w.x = cvt_pk(y[0], y[1]); w.y = cvt_pk(y[2], y[3]); *(u32x2*)(XC + (size_t)(R + rw) * DM + lane * 4 + 256 * j) = w; } } }
                } else {
                    for (int R = 4 * gw; R < MR; R += 4 * NGW) { const int b = R / NT, n = R - b * NT; const bool isc = n >= TL;
                        if (isc && sub == 5 && l == 1) continue;
                        const bf16_t* xr = XR + (size_t)R * DM + lane * 4; const float* mp = modl + (isc ? 32 : b) * 6144 + lane * 4;
                        u32x2 q[4][4]; float ss[4];
#pragma unroll
                        for (int rw = 0; rw < 4; ++rw)
#pragma unroll
                            for (int j = 0; j < 4; ++j) q[rw][j] = *(const u32x2*)(xr + (size_t)rw * DM + 256 * j);
#pragma unroll
                        for (int rw = 0; rw < 4; ++rw) { float s_ = 0.f;
#pragma unroll
                            for (int j = 0; j < 4; ++j) { const float a0 = bflo(q[rw][j].x), a1 = bfhi(q[rw][j].x), a2 = bflo(q[rw][j].y), a3 = bfhi(q[rw][j].y); s_ += (a0 * a0 + a1 * a1) + (a2 * a2 + a3 * a3); }
                            ss[rw] = rsqrtf(wave_sum(s_) * (1.f / DM) + EPS); }
#pragma unroll
                        for (int j = 0; j < 4; ++j) { const f32x4 g4 = *(const f32x4*)(gain + lane * 4 + 256 * j), sc = *(const f32x4*)(mp + scoff + 256 * j) + 1.f, sh = *(const f32x4*)(mp + shoff + 256 * j); const f32x4 gs = g4 * sc;
#pragma unroll
                            for (int rw = 0; rw < 4; ++rw) { const f32x4 v = (f32x4){bflo(q[rw][j].x), bfhi(q[rw][j].x), bflo(q[rw][j].y), bfhi(q[rw][j].y)}; const f32x4 y = (v * ss[rw]) * gs + sh; u32x2 w;
                                w.x = cvt_pk(y[0], y[1]); w.y = cvt_pk(y[2], y[3]); *(u32x2*)(XC + (size_t)(R + rw) * DM + lane * 4 + 256 * j) = w; } } }
                }
            } else if (sub == 1 && EN(2)) {
                pg8::Gemm g{XC, WIN + (size_t)l * INP * DM, (long)NT * DM, 0, DM, DM, NB, 9, 11};
                pg8::EpiP E{PB, STAT}; REP(3) pg8::gemm_phase(lds, g, G, bx, E);
            } else if (sub == 2 && EN(3)) {
                REP(6) {
                if (EN(10)) { pg8::Gemm g{WS + 2048, PB + O_FN, 0, (long)NT * INP, INP, 256, NB, 2, l == 0 ? 9 : 8};
                  pg8::EpiBf<true> E{ZC, 512L * TL, TL, 0, ZCC, 512L * TC, TC, 8}; pg8::gemm_phase(lds, g, G, bx, E); }
                if (EN(11)) { pg8::Gemm g{PB, WS + l * 1024, (long)NT * INP, 0, INP, 256, NB, l == 0 ? 9 : 8, 3};
                  pg8::EpiQK<true> E{QB, 192, STAT, COST, SINT}; pg8::gemm_phase(lds, g, G, bx, E); }
                if (EN(12)) { pg8::Gemm g{PB + O_CKV, WS + l * 1024 + 256, (long)NT * INP, 0, INP, 256, NB, 9, 3};
                  pg8::EpiQK<false> E{KB, KP, STAT, COST, SINT}; pg8::gemm_phase(lds, g, G, bx, E); }
                if (EN(13)) { pg8::Gemm g{WS + l * 1024 + 512, PB + O_CKV, 0, (long)NT * INP, INP, 256, NB, 2, 9};
                  pg8::EpiVt E{VT, STAT}; pg8::gemm_phase(lds, g, G, bx, E); }
                }
                if (EN(14)) REP(0) for (int j = bx; j < NB * 8; j += G) scan_job(lds, j >> 3, (j >> 1) & 3, j & 1, l, PB, lbp, XC, OB);
            } else if (sub == 3 && EN(4)) {
                if (EN(15)) { pg8::Gemm g{DMAT, ZC, 0, 512L * TL, 4096, 4096, NB, 8, 1};
                  pg8::EpiBf<true> E{XC, (long)NT * DM, DM, 768, XC, 0, DM, 1 << 30}; REP(5) pg8::gemm_phase(lds, g, G, bx, E); }
                if (l == 0 && EN(16)) { pg8::Gemm g{DCM, ZCC, 0, 512L * TC, 512, 512, NB, 1, 1};
                  pg8::EpiBf<true> E{XC + (size_t)TL * DM, (long)NT * DM, DM, 768, XC, 0, DM, 1 << 30}; pg8::gemm_phase(lds, g, G, bx, E); }
                __syncthreads();
                if (EN(17)) { const int nun = NB * 4 * 8 + (l == 0 ? NB * 4 : 0);
                  REP(1) for (int un = vcu; un < nun; un += G) {
                      if (un < NB * 32) { const int bh = un >> 3, qb = un & 7; attn_unit(lds, bh >> 2, bh & 3, qb * 256, 0, NT / 64, QB, KB, VT, XC); }
                      else { const int bh = un - NB * 32; attn_unit(lds, bh >> 2, bh & 3, TL, TL, TC / 64, QB, KB, VT, XC); } } }
                if (EN(18)) for (int R0 = 2 * gw; R0 < MR; R0 += 2 * NGW) { const int b = R0 / NT, n = R0 - b * NT; if (n >= TL && l == 1) continue;
                    const int col = lane * 4; const f32x4 g4 = *(const f32x4*)(hgg + l * 256 + col);
                    u32x2 fw[2], bw[2], zw[2];
#pragma unroll
                    for (int q = 0; q < 2; ++q) { const size_t R = (size_t)R0 + q; fw[q] = *(const u32x2*)(XC + R * DM + 512 + col); bw[q] = *(const u32x2*)(OB + R * 256 + col); zw[q] = *(const u32x2*)(PB + R * INP + O_HG + col); }
#pragma unroll
                    for (int q = 0; q < 2; ++q) { const size_t R = (size_t)R0 + q;
                        float o[4] = {bflo(fw[q].x) + bflo(bw[q].x), bfhi(fw[q].x) + bfhi(bw[q].x), bflo(fw[q].y) + bflo(bw[q].y), bfhi(fw[q].y) + bfhi(bw[q].y)};
                        float ss = (o[0] * o[0] + o[1] * o[1]) + (o[2] * o[2] + o[3] * o[3]);
                        ss += __shfl_xor(ss, 1); ss += __shfl_xor(ss, 2); ss += __shfl_xor(ss, 4); ss += __shfl_xor(ss, 8);
                        const float r = rsqrtf(ss * (1.f / 64.f) + EPS);
                        const float z[4] = {bflo(zw[q].x), bfhi(zw[q].x), bflo(zw[q].y), bfhi(zw[q].y)}; float y[4];
#pragma unroll
                        for (int i = 0; i < 4; ++i) y[i] = o[i] * r * g4[i] * silu_f(z[i]);
                        u32x2 w; w.x = cvt_pk(y[0], y[1]); w.y = cvt_pk(y[2], y[3]); *(u32x2*)(XC + R * DM + 512 + col) = w; } }
            } else if (sub == 4 && EN(5)) {
                pg8::Gemm g{XC, WOUT + (size_t)l * DM * DM, (long)NT * DM, 0, DM, DM, NB, l == 0 ? 9 : 8, 4};
                pg8::EpiRes<l == 0> E{x_in, ctx_in, XR, XR, modl + 2048}; pg8::gemm_phase(lds, g, G, bx, E);
            } else if (sub == 6 && EN(6)) {
                pg8::Gemm g{XC, WGU + (size_t)l * 5632 * DM, (long)NT * DM, 0, DM, DM, NB, l == 0 ? 9 : 8, 22};
                pg8::EpiGU E{PB}; REP(2) pg8::gemm_phase(lds, g, G, bx, E);
            } else if (sub == 7 && EN(7)) {
                pg8::Gemm g{PB, WDN + (size_t)l * DM * FF, (long)NT * FF, 0, FF, FF, NB, l == 0 ? 9 : 8, 4};
                pg8::EpiRes<false> E{x_in, ctx_in, XR, l == 0 ? XR : XC, modl + 5120}; pg8::gemm_phase(lds, g, G, bx, E);
            }
        }
}

__global__ void __launch_bounds__(512, 2) mk_fwd(Args args) {
    extern __shared__ __attribute__((aligned(16))) unsigned char lds_raw[];
    LAS unsigned char* lds = (LAS unsigned char*)lds_raw;
    XcdBarrier bar; bar.bar = (unsigned*)(args.ws + W_CTL); bar.x = 0; bar.st = nullptr;
    if (args.ph_hi - args.ph_lo > 1) {
        if (threadIdx.x < 2) ((volatile LAS unsigned*)(lds + LDS_BARST))[threadIdx.x] = 0u;
        __syncthreads();
        bar = xcd_barrier_post((unsigned*)(args.ws + W_CTL), (volatile LAS unsigned*)(lds + LDS_BARST));
    }
#define PHASE(k) if (args.ph_lo <= (k) && (k) < args.ph_hi) { phase_body<k>(args, lds); if ((k) + 1 < args.ph_hi) { if ((k) == 0) cg::this_grid().sync(); else xcd_barrier(bar); } }
    PHASE(0) PHASE(1) PHASE(2) PHASE(3) PHASE(4) PHASE(5) PHASE(6) PHASE(7) PHASE(8) PHASE(9) PHASE(10) PHASE(11) PHASE(12) PHASE(13) PHASE(14) PHASE(15) PHASE(16) PHASE(17)
#undef PHASE
}

extern "C" void kernel_launch(void* const* d_in, const int* in_sizes, int n_in, void* d_out, int out_size, void* d_ws, size_t ws_size, hipStream_t stream) {
    static int grid = 0;
    if (grid == 0) {
        if (n_in != 20 || out_size != NB * TL * DM || ws_size < W_END) { fprintf(stderr, "kernel_launch: unexpected problem (n_in %d out %d ws %zu need %zu)\n", n_in, out_size, ws_size, (size_t)W_END); grid = -1; return; }
        int dev = 0, cus = 0, per_cu = 0;
        hipGetDevice(&dev); hipDeviceGetAttribute(&cus, hipDeviceAttributeMultiprocessorCount, dev);
        if (hipFuncSetAttribute((const void*)mk_fwd, hipFuncAttributeMaxDynamicSharedMemorySize, LDS_BYTES) != hipSuccess) { fprintf(stderr, "kernel_launch: hipFuncSetAttribute failed\n"); grid = -1; return; }
        if (hipOccupancyMaxActiveBlocksPerMultiprocessor(&per_cu, (const void*)mk_fwd, 512, LDS_BYTES) != hipSuccess || per_cu < 1) { fprintf(stderr, "kernel_launch: occupancy query gave %d\n", per_cu); per_cu = 1; }
        (void)hipGetLastError();
        grid = cus * (per_cu > 1 ? 1 : per_cu);
        if (grid <= 0) grid = 256;
    }
    if (grid < 0) return;
    Args a{};
    for (int i = 0; i < 20; ++i) a.in[i] = (const float*)d_in[i];
    a.out = (float*)d_out; a.ws = (unsigned char*)d_ws;
#if MK_MULTI
    for (int ph = 0; ph < NPHASE; ++ph) { a.ph_lo = ph; a.ph_hi = ph + 1; hipLaunchKernelGGL(mk_fwd, dim3(grid), dim3(512), LDS_BYTES, stream, a); }
#else
    a.ph_lo = 0; a.ph_hi = NPHASE;
    if (hipMemsetAsync((char*)d_ws + W_CTL, 0, CTL_BYTES, stream) != hipSuccess) { fprintf(stderr, "kernel_launch: memset failed\n"); return; }
    void* kargs[] = {&a};
    hipError_t e = hipLaunchCooperativeKernel((const void*)mk_fwd, dim3(grid), dim3(512), kargs, LDS_BYTES, stream);
    if (e != hipSuccess) fprintf(stderr, "kernel_launch: cooperative launch failed: %s (grid %d)\n", hipGetErrorString(e), grid);
#endif
}
```

```cpp
#include <hip/hip_runtime.h>
#include <hip/hip_cooperative_groups.h>
#include <cstdio>
#include <cstdint>
namespace cg = cooperative_groups;

#ifndef MK_MULTI
#define MK_MULTI 0
#endif

#ifndef ONLY_MASK
#define ONLY_MASK 0x7ffff
#endif
#define EN(k) (((ONLY_MASK) >> (k)) & 1)
#ifndef DUP
#define DUP 0
#endif
#define REP(bit) for (int rep_ = 0; rep_ < (((DUP) >> (bit)) & 1) + 1; ++rep_)
#define LAS __attribute__((address_space(3)))
typedef unsigned short bf16_t;
typedef short bf16x8 __attribute__((ext_vector_type(8)));
typedef short s16x4 __attribute__((ext_vector_type(4)));
typedef float f32x4 __attribute__((ext_vector_type(4)));
typedef float f32x16 __attribute__((ext_vector_type(16)));
typedef unsigned u32x4 __attribute__((ext_vector_type(4)));
typedef unsigned u32x2 __attribute__((ext_vector_type(2)));

constexpr int NB = 32, TL = 2048, TC = 256, NT = 2304, MR = NB * NT, DM = 1024;
constexpr int INW = 2752, INP = 2816, FF = 2816;
constexpr int O_CKV = 256, O_KR = 384, O_HQ = 448, O_HFF = 960, O_HFB = 1472, O_HI = 1984, O_HG = 2240, O_FN = 2496;
constexpr float EPS = 1e-6f;
constexpr int KP = 200;
constexpr float QSCALE = 0.07216878364870322f * 1.4426950408889634f;

constexpr size_t MiB = 1u << 20;
constexpr size_t W_WIN = 0;
constexpr size_t W_WGU = W_WIN + 2ull * INP * DM * 2;
constexpr size_t W_WDN = W_WGU + 2ull * 5632 * DM * 2;
constexpr size_t W_WOUT = W_WDN + 2ull * DM * FF * 2;
constexpr size_t W_WS = W_WOUT + 2ull * DM * DM * 2;
constexpr size_t W_DM = W_WS + 768ull * INP * 2;
constexpr size_t W_DC = W_DM + 2048ull * 4096 * 2;
constexpr size_t W_COS = W_DC + 256ull * 512 * 2;
constexpr size_t W_SIN = W_COS + 2048ull * 32 * 4;
constexpr size_t W_MOD = W_SIN + 2048ull * 32 * 4;
constexpr size_t W_STAT = W_MOD + 2ull * 33 * 6144 * 4;
constexpr size_t W_OB = (W_STAT + (size_t)MR * 8 * 4 + 4095) / 4096 * 4096;
constexpr size_t W_ZC = W_OB + (size_t)MR * 256 * 2;
constexpr size_t W_ZCC = W_ZC + 32ull * 512 * 2048 * 2;
constexpr size_t W_VT = W_ZCC + 32ull * 512 * 256 * 2;
constexpr size_t W_K = W_VT + 32ull * 512 * NT * 2;
constexpr size_t W_Q = W_K + 128ull * NT * KP * 2;
constexpr size_t W_XC = W_Q + 128ull * NT * 192 * 2;
constexpr size_t W_P = W_XC + (size_t)MR * DM * 2;
constexpr size_t W_CTL = W_P + (size_t)MR * INP * 2;
constexpr size_t CTL_BYTES = 16384;
constexpr size_t W_END = W_CTL + CTL_BYTES;

constexpr int LDS_BYTES = 147456;
constexpr int NPHASE = 18;

__device__ __forceinline__ unsigned cvt_pk(float lo, float hi) { unsigned r; asm volatile("v_cvt_pk_bf16_f32 %0, %1, %2" : "=v"(r) : "v"(lo), "v"(hi)); return r; }
__device__ __forceinline__ unsigned f2bf(float f) { unsigned u = __builtin_bit_cast(unsigned, f); return (u + 0x7fffu + ((u >> 16) & 1u)) >> 16; }
__device__ __forceinline__ float bf2f(unsigned short h) { return __builtin_bit_cast(float, (unsigned)h << 16); }
__device__ __forceinline__ float bflo(unsigned w) { return __builtin_bit_cast(float, w << 16); }
__device__ __forceinline__ float bfhi(unsigned w) { return __builtin_bit_cast(float, w & 0xffff0000u); }
__device__ __forceinline__ float wave_sum(float v) {
#pragma unroll
    for (int o = 1; o < 64; o <<= 1) v += __shfl_xor(v, o);
    return v;
}
__device__ __forceinline__ float silu_f(float x) { return x / (1.f + __expf(-x)); }
__device__ __forceinline__ float sigm_f(float x) { return 1.f / (1.f + __expf(-x)); }

namespace pg8 {
constexpr int BM = 256, BK = 64, HALF = 128, HTB = HALF * BK * 2, NXCD = 8, WGM = 8;
__device__ __forceinline__ int lds_byte(int r, int c) { const int st = (r >> 4) * 2 + (c >> 5), rr = r & 15, cc = c & 31, ob = rr * 64 + cc * 2; return st * 1024 + (ob ^ (((ob >> 9) & 1) << 5)); }
__device__ __forceinline__ void stage_rc(int b, int& R, int& C) { const int st = b / 1024, sb = b % 1024, swz = sb ^ (((sb >> 9) & 1) << 5); R = (st >> 1) * 16 + swz / 64; C = (st & 1) * 32 + (swz % 64) / 2; }

__device__ __forceinline__ int perm32(int rho) { const int n = rho >> 4, i = rho & 15; return 8 * (i >> 2) + 4 * n + (i & 3); }
struct Unit { int pb, pm, pn; };
struct Gemm { const bf16_t* A; const bf16_t* Bt; long sA, sB; int ld, K, nb, nM, nN; };
struct Order {
    int nM, nN, per, nwg, G, c;
    __device__ __forceinline__ void init(const Gemm& g, int G_, int c_) { nM = g.nM; nN = g.nN; per = nM * nN; nwg = per * g.nb; G = G_; c = c_; }
    __device__ __forceinline__ bool next(int i, Unit& u) const {
        const long L = (long)i * G + c; if (L >= nwg) return false;
        int w = (int)L; { const int q = nwg / NXCD, r = nwg % NXCD, xcd = w % NXCD, off = w / NXCD; w = (xcd < r ? xcd * (q + 1) : r * (q + 1) + (xcd - r) * q) + off; }
        u.pb = w / per; w -= u.pb * per;
        const int nig = WGM * nN, gid = w / nig, fm = gid * WGM, gsz = (nM - fm) < WGM ? (nM - fm) : WGM;
        u.pm = fm + ((w % nig) % gsz); u.pn = (w % nig) / gsz; return true;
    }
};
template <class Epi>
__device__ __forceinline__ void gemm_phase(LAS unsigned char* lds, const Gemm g, int G, int c, const Epi& E) {
    int tid = threadIdx.x; asm volatile("" : "+v"(tid));
    const int wid = __builtin_amdgcn_readfirstlane(tid >> 6), lane = tid & 63, wr = wid >> 2, wc = wid & 3, fr = lane & 15, fq = lane >> 4;
    const int nt = g.K / BK;
    Order S; S.init(g, G, c);
    unsigned voffA[2], voffB[2];
#pragma unroll
    for (int i = 0; i < 2; ++i) { int R, C; stage_rc(tid * 16 + i * 8192, R, C); const int Rb = Epi::PERM ? ((R & ~31) + perm32(R & 31)) : R;
        voffA[i] = (unsigned)(R * g.ld + C) * 2u; voffB[i] = Epi::PERM ? (unsigned)(Rb * g.ld + C) * 2u : voffA[i]; }
    const size_t kstep = (size_t)(BK * 2);
    const size_t hstepA = (size_t)HALF * g.ld * 2, hstepB = hstepA;
    const unsigned ldsw = (unsigned)wid * 1024u;
    const int aoff = lds_byte(wr * 64 + fr, fq * 8), boff = lds_byte(wc * 32 + fr, fq * 8);
#define PG8_SA(b, h) (((b) * 2 + (h)) * HTB)
#define PG8_SB(b, h) ((4 + (b) * 2 + (h)) * HTB)
#define PG8_STAGE(bufoff, gbase, voff) do { _Pragma("unroll") for (int _i = 0; _i < 2; ++_i) \
        __builtin_amdgcn_global_load_lds((const unsigned*)((const char*)(gbase) + (voff)[_i]), (LAS unsigned*)(lds + (bufoff) + ldsw + _i * 8192), 16, 0, 0); } while (0)
#define PG8_LDA(dst, b, h) do { _Pragma("unroll") for (int m = 0; m < 4; ++m) _Pragma("unroll") for (int k = 0; k < 2; ++k) dst[m][k] = *(const LAS bf16x8*)(lds + PG8_SA(b, h) + aoff + m * 2048 + k * 1024); } while (0)
#define PG8_LDB(dst, b, h) do { _Pragma("unroll") for (int n = 0; n < 2; ++n) _Pragma("unroll") for (int k = 0; k < 2; ++k) dst[n][k] = *(const LAS bf16x8*)(lds + PG8_SB(b, h) + boff + n * 2048 + k * 1024); } while (0)
#define PG8_MMA(ai, bj, At, Bt) do { __builtin_amdgcn_s_setprio(1); _Pragma("unroll") for (int m = 0; m < 4; ++m) _Pragma("unroll") for (int n = 0; n < 2; ++n) _Pragma("unroll") for (int k = 0; k < 2; ++k) \
        acc[ai][bj][m][n] = __builtin_amdgcn_mfma_f32_16x16x32_bf16(Bt[n][k], At[m][k], acc[ai][bj][m][n], 0, 0, 0); __builtin_amdgcn_s_setprio(0); } while (0)
#define PG8_WAIT_V(n) asm volatile("s_waitcnt vmcnt(" #n ")" ::: "memory")
#define PG8_WAIT_L(n) asm volatile("s_waitcnt lgkmcnt(" #n ")" ::: "memory")
#define PG8_BAR __builtin_amdgcn_s_barrier()
#define PG8_SCHED __builtin_amdgcn_sched_barrier(0)
    Unit cur, nxt; int ui = 0;
    if (!S.next(0, cur)) return;
    f32x4 acc[2][2][4][2];
#pragma unroll
    for (int a = 0; a < 2; ++a)
#pragma unroll
        for (int b = 0; b < 2; ++b)
#pragma unroll
            for (int m = 0; m < 4; ++m)
#pragma unroll
                for (int n = 0; n < 2; ++n) acc[a][b][m][n] = (f32x4){0.f, 0.f, 0.f, 0.f};
    bf16x8 At[4][2], B0[2][2], B1[2][2];
    const char* cA = (const char*)(g.A + (size_t)cur.pb * g.sA) + (size_t)cur.pm * 2 * hstepA;
    const char* cB = (const char*)(g.Bt + (size_t)cur.pb * g.sB) + (size_t)cur.pn * 2 * hstepB;
    PG8_STAGE(PG8_SB(0, 0), cB, voffB); PG8_STAGE(PG8_SB(0, 1), cB + hstepB, voffB); PG8_STAGE(PG8_SA(0, 0), cA, voffA); PG8_STAGE(PG8_SA(0, 1), cA + hstepA, voffA);
    if (wr == 1) PG8_BAR;
    PG8_WAIT_V(2); PG8_BAR;
    PG8_STAGE(PG8_SB(1, 0), cB + kstep, voffB); PG8_STAGE(PG8_SA(1, 0), cA + kstep, voffA); PG8_STAGE(PG8_SB(1, 1), cB + hstepB + kstep, voffB);
    PG8_WAIT_V(6); PG8_BAR;
    for (;;) {
        const bool has_next = S.next(ui + 1, nxt);
        const char* nA = has_next ? (const char*)(g.A + (size_t)nxt.pb * g.sA) + (size_t)nxt.pm * 2 * hstepA : cA;
        const char* nB = has_next ? (const char*)(g.Bt + (size_t)nxt.pb * g.sB) + (size_t)nxt.pn * 2 * hstepB : cB;
#pragma nounroll
        for (int t = 0; t < nt; t += 2) {
            const bool last = (t == nt - 2);
            const char* a1 = cA + (size_t)(t + 1) * kstep;
            const char* a2 = last ? nA : cA + (size_t)(t + 2) * kstep; const char* b2 = last ? nB : cB + (size_t)(t + 2) * kstep;
            const char* a3 = a2 + kstep; const char* b3 = b2 + kstep;
            PG8_LDB(B0, 0, 0); PG8_LDB(B1, 0, 1); PG8_SCHED; PG8_LDA(At, 0, 0); PG8_STAGE(PG8_SA(1, 1), a1 + hstepA, voffA);
            PG8_WAIT_V(8); PG8_WAIT_L(0); PG8_BAR; PG8_MMA(0, 0, At, B0); PG8_MMA(0, 1, At, B1); PG8_BAR; PG8_SCHED;
            PG8_LDA(At, 0, 1); PG8_STAGE(PG8_SB(0, 0), b2, voffB); PG8_STAGE(PG8_SB(0, 1), b2 + hstepB, voffB); PG8_STAGE(PG8_SA(0, 0), a2, voffA);
            PG8_WAIT_V(8); PG8_WAIT_L(0); PG8_BAR; PG8_MMA(1, 0, At, B0); PG8_MMA(1, 1, At, B1); PG8_BAR; PG8_SCHED;
            PG8_LDB(B0, 1, 0); PG8_LDB(B1, 1, 1); PG8_SCHED; PG8_LDA(At, 1, 0); PG8_STAGE(PG8_SA(0, 1), a2 + hstepA, voffA);
            PG8_WAIT_V(8); PG8_WAIT_L(0); PG8_BAR; PG8_MMA(0, 0, At, B0); PG8_MMA(0, 1, At, B1); PG8_BAR; PG8_SCHED;
            PG8_LDA(At, 1, 1); PG8_STAGE(PG8_SB(1, 0), b3, voffB); PG8_STAGE(PG8_SB(1, 1), b3 + hstepB, voffB); PG8_STAGE(PG8_SA(1, 0), a3, voffA);
            PG8_WAIT_V(8); PG8_WAIT_L(0); PG8_BAR; PG8_MMA(1, 0, At, B0); PG8_MMA(1, 1, At, B1); PG8_BAR; PG8_SCHED;
        }
        if (wr == 0) PG8_BAR;
        { int l2 = lane; asm volatile("" : "+v"(l2)); E(acc, cur, wr, wc, l2 & 15, l2 >> 4); }
        if (!has_next) break;
#pragma unroll
        for (int a = 0; a < 2; ++a)
#pragma unroll
            for (int b = 0; b < 2; ++b)
#pragma unroll
                for (int m = 0; m < 4; ++m)
#pragma unroll
                    for (int n = 0; n < 2; ++n) acc[a][b][m][n] = (f32x4){0.f, 0.f, 0.f, 0.f};
        cur = nxt; cA = nA; cB = nB; ++ui;
        if (wr == 1) PG8_BAR;
    }
    PG8_WAIT_V(0);
    PG8_BAR;
#undef PG8_SA
#undef PG8_SB
#undef PG8_STAGE
#undef PG8_LDA
#undef PG8_LDB
#undef PG8_MMA
#undef PG8_WAIT_V
#undef PG8_WAIT_L
#undef PG8_BAR
#undef PG8_SCHED
}

typedef f32x4 Acc[2][2][4][2];
struct EpiP {
    static constexpr bool PERM = true;
    bf16_t* P; float* stats;
    __device__ __forceinline__ void operator()(const Acc& acc, const Unit& u, int wr, int wc, int fr, int fq) const {
        const size_t Rb = (size_t)u.pb * NT + u.pm * 256 + wr * 64 + fr; const int col0 = u.pn * 256 + wc * 32 + 8 * fq;
#pragma unroll
        for (int ai = 0; ai < 2; ++ai)
#pragma unroll
            for (int m = 0; m < 4; ++m) { const size_t R = Rb + ai * 128 + m * 16; bf16_t* rowp = P + R * INP + col0;
#pragma unroll
                for (int bj = 0; bj < 2; ++bj) { const f32x4 v0 = acc[ai][bj][m][0], v1 = acc[ai][bj][m][1]; u32x4 w; w.x = cvt_pk(v0[0], v0[1]); w.y = cvt_pk(v0[2], v0[3]); w.z = cvt_pk(v1[0], v1[1]); w.w = cvt_pk(v1[2], v1[3]);
                    *(u32x4*)(rowp + bj * 128) = w; }
                if (u.pn < 2) { float s = 0.f;
#pragma unroll
                    for (int n = 0; n < 2; ++n) { const f32x4 v = acc[ai][0][m][n]; s += (v[0] * v[0] + v[1] * v[1]) + (v[2] * v[2] + v[3] * v[3]); }
                    if (u.pn == 0) {
#pragma unroll
                        for (int n = 0; n < 2; ++n) { const f32x4 v = acc[ai][1][m][n]; s += (v[0] * v[0] + v[1] * v[1]) + (v[2] * v[2] + v[3] * v[3]); } }
                    s += __shfl_xor(s, 16); s += __shfl_xor(s, 32);
                    if (fq == 0) stats[R * 8 + u.pn * 4 + wc] = s; } }
    }
};
template <bool ISQ> struct EpiQK {
    static constexpr bool PERM = true;
    bf16_t* O; int pitch; const float* stats; const float* cosT; const float* sinT;
    __device__ __forceinline__ void operator()(const Acc& acc, const Unit& u, int wr, int wc, int fr, int fq) const {
#pragma unroll
        for (int ai = 0; ai < 2; ++ai)
#pragma unroll
            for (int m = 0; m < 4; ++m) { const int row = u.pm * 256 + ai * 128 + wr * 64 + m * 16 + fr; const size_t R = (size_t)u.pb * NT + row;
                const f32x4 sa = *(const f32x4*)(stats + R * 8 + (ISQ ? 0 : 4));
                float rr = rsqrtf(((sa[0] + sa[1]) + (sa[2] + sa[3])) * (ISQ ? (1.f / 256.f) : (1.f / 128.f)) + EPS); if (ISQ) rr *= QSCALE;
#pragma unroll
                for (int bj = 0; bj < 2; ++bj) { const int cg_ = u.pn * 256 + bj * 128 + wc * 32; const int h = cg_ / 192, d0 = cg_ - h * 192;
                    f32x4 a = acc[ai][bj][m][0], b = acc[ai][bj][m][1];
                    if (d0 < 128) { a = a * rr; b = b * rr; }
                    else { if (ISQ) { a = a * rr; b = b * rr; }
                        f32x4 pa, pb;
#pragma unroll
                        for (int i = 0; i < 4; ++i) { pa[i] = __shfl_xor(a[i], 32); pb[i] = __shfl_xor(b[i], 32); }
                        if (row < TL) { const int ti = row * 32 + ((d0 - 128) >> 5) * 16 + 8 * (fq & 1); const float sg = fq < 2 ? -1.f : 1.f;
                            const f32x4 c0 = *(const f32x4*)(cosT + ti), c1 = *(const f32x4*)(cosT + ti + 4), s0 = *(const f32x4*)(sinT + ti) * sg, s1 = *(const f32x4*)(sinT + ti + 4) * sg;
                            a = a * c0 + pa * s0; b = b * c1 + pb * s1; } }
                    bf16_t* dst = O + ((size_t)(u.pb * 4 + h) * NT + row) * pitch + d0 + 8 * fq;
                    u32x4 w; w.x = cvt_pk(a[0], a[1]); w.y = cvt_pk(a[2], a[3]); w.z = cvt_pk(b[0], b[1]); w.w = cvt_pk(b[2], b[3]); *(u32x4*)dst = w; } }
    }
};
struct EpiVt {
    static constexpr bool PERM = true;
    bf16_t* Vt; const float* stats;
    __device__ __forceinline__ void operator()(const Acc& acc, const Unit& u, int wr, int wc, int fr, int fq) const {
        f32x4 rk[2][2];
#pragma unroll
        for (int bj = 0; bj < 2; ++bj)
#pragma unroll
            for (int n = 0; n < 2; ++n) { const int col = u.pn * 256 + bj * 128 + wc * 32 + 8 * fq + 4 * n;
#pragma unroll
                for (int i = 0; i < 4; ++i) { const f32x4 sa = *(const f32x4*)(stats + ((size_t)u.pb * NT + col + i) * 8 + 4); rk[bj][n][i] = rsqrtf(((sa[0] + sa[1]) + (sa[2] + sa[3])) * (1.f / 128.f) + EPS); } }
#pragma unroll
        for (int ai = 0; ai < 2; ++ai)
#pragma unroll
            for (int m = 0; m < 4; ++m) { const int row = u.pm * 256 + ai * 128 + wr * 64 + m * 16 + fr; bf16_t* rowp = Vt + ((size_t)u.pb * 512 + row) * NT + u.pn * 256 + wc * 32 + 8 * fq;
#pragma unroll
                for (int bj = 0; bj < 2; ++bj) { const f32x4 v0 = acc[ai][bj][m][0] * rk[bj][0], v1 = acc[ai][bj][m][1] * rk[bj][1]; u32x4 w; w.x = cvt_pk(v0[0], v0[1]); w.y = cvt_pk(v0[2], v0[3]); w.z = cvt_pk(v1[0], v1[1]); w.w = cvt_pk(v1[2], v1[3]);
                    *(u32x4*)(rowp + bj * 128) = w; } }
    }
};
template <bool PM> struct EpiBf {
    static constexpr bool PERM = PM;
    bf16_t* O; long sO; int ldc, coff; bf16_t* O2; long sO2; int ldc2, split;
    __device__ __forceinline__ void operator()(const Acc& acc, const Unit& u, int wr, int wc, int fr, int fq) const {
        const bool second = u.pn >= split; bf16_t* base = second ? O2 + (size_t)u.pb * sO2 : O + (size_t)u.pb * sO + coff; const int ld = second ? ldc2 : ldc;
        const int col0 = (second ? u.pn - split : u.pn) * 256 + wc * 32 + (PM ? 8 : 4) * fq;
#pragma unroll
        for (int ai = 0; ai < 2; ++ai)
#pragma unroll
            for (int m = 0; m < 4; ++m) { const int row = u.pm * 256 + ai * 128 + wr * 64 + m * 16 + fr; bf16_t* rowp = base + (size_t)row * ld + col0;
#pragma unroll
                for (int bj = 0; bj < 2; ++bj) { const f32x4 v0 = acc[ai][bj][m][0], v1 = acc[ai][bj][m][1]; u32x4 w; w.x = cvt_pk(v0[0], v0[1]); w.y = cvt_pk(v0[2], v0[3]); w.z = cvt_pk(v1[0], v1[1]); w.w = cvt_pk(v1[2], v1[3]);
                    if (PM) *(u32x4*)(rowp + bj * 128) = w; else { *(u32x2*)(rowp + bj * 128) = (u32x2){w.x, w.y}; *(u32x2*)(rowp + bj * 128 + 16) = (u32x2){w.z, w.w}; } } }
    }
};
template <bool INF32> struct EpiRes {
    static constexpr bool PERM = true;
    const float* inL; const float* inC; const bf16_t* inB; bf16_t* outB; const float* gate;
    __device__ __forceinline__ void operator()(const Acc& acc, const Unit& u, int wr, int wc, int fr, int fq) const {
        const bool isc = u.pm == 8;
        const size_t rb = isc ? (size_t)u.pb * TC : (size_t)u.pb * TL + u.pm * 256;
        const float* in = (isc ? inC : inL) + rb * DM; const float* gp = gate + (isc ? 32 : u.pb) * 6144;
        const int col0 = u.pn * 256 + wc * 32 + 8 * fq; const size_t Rg = (size_t)u.pb * NT + u.pm * 256;
        f32x4 gv[2][2];
#pragma unroll
        for (int bj = 0; bj < 2; ++bj)
#pragma unroll
            for (int n = 0; n < 2; ++n) gv[bj][n] = *(const f32x4*)(gp + col0 + bj * 128 + n * 4);
#pragma unroll
        for (int ai = 0; ai < 2; ++ai)
#pragma unroll
            for (int m = 0; m < 4; ++m) { const int rl = ai * 128 + wr * 64 + m * 16 + fr; const size_t off = (size_t)rl * DM + col0; const size_t boff = (Rg + rl) * DM + col0;
#pragma unroll
                for (int bj = 0; bj < 2; ++bj) { f32x4 x0, x1;
                    if (INF32) { x0 = *(const f32x4*)(in + off + bj * 128); x1 = *(const f32x4*)(in + off + bj * 128 + 4); }
                    else { const u32x4 q = *(const u32x4*)(inB + boff + bj * 128); x0 = (f32x4){bflo(q.x), bfhi(q.x), bflo(q.y), bfhi(q.y)}; x1 = (f32x4){bflo(q.z), bfhi(q.z), bflo(q.w), bfhi(q.w)}; }
                    x0 = x0 + gv[bj][0] * acc[ai][bj][m][0]; x1 = x1 + gv[bj][1] * acc[ai][bj][m][1];
                    u32x4 w; w.x = cvt_pk(x0[0], x0[1]); w.y = cvt_pk(x0[2], x0[3]); w.z = cvt_pk(x1[0], x1[1]); w.w = cvt_pk(x1[2], x1[3]); *(u32x4*)(outB + boff + bj * 128) = w; } }
    }
};
struct EpiGU {
    static constexpr bool PERM = true;
    bf16_t* H;
    __device__ __forceinline__ void operator()(const Acc& acc, const Unit& u, int wr, int wc, int fr, int fq) const {
        const size_t Rb = (size_t)u.pb * NT + u.pm * 256 + wr * 64 + fr; const int col0 = u.pn * 128 + wc * 32 + 8 * fq;
#pragma unroll
        for (int ai = 0; ai < 2; ++ai)
#pragma unroll
            for (int m = 0; m < 4; ++m) { bf16_t* rowp = H + (Rb + ai * 128 + m * 16) * FF + col0; f32x4 v[2];
#pragma unroll
                for (int n = 0; n < 2; ++n) { const f32x4 gt = acc[ai][0][m][n], up = acc[ai][1][m][n];
#pragma unroll
                    for (int i = 0; i < 4; ++i) v[n][i] = gt[i] * __builtin_amdgcn_rcpf(1.f + __builtin_amdgcn_exp2f(-1.4426950408889634f * gt[i])) * up[i]; }
                u32x4 w; w.x = cvt_pk(v[0][0], v[0][1]); w.y = cvt_pk(v[0][2], v[0][3]); w.z = cvt_pk(v[1][0], v[1][1]); w.w = cvt_pk(v[1][2], v[1][3]); *(u32x4*)rowp = w; }
    }
};
}

constexpr int AK_BYTES = 64 * KP * 2  , AV_PITCH = 136, AV_BYTES = 128 * AV_PITCH  ;
__device__ __forceinline__ void attn_unit(LAS unsigned char* lds, int b, int h, int q0, int kbeg, int ntiles, const bf16_t* Q, const bf16_t* K, const bf16_t* Vt, bf16_t* cat) {
    int tid = threadIdx.x; asm volatile("" : "+v"(tid));
    const int lane = tid & 63, r32 = lane & 31, hi = lane >> 5; const int wid = __builtin_amdgcn_readfirstlane(tid >> 6);
    const char* Kg = (const char*)(K + ((size_t)(b * 4 + h) * NT + kbeg) * KP);
    const bf16_t* Vg = Vt + (size_t)(b * 4 + h) * 128 * NT + kbeg;
    bf16x8 qf[12];
    { const bf16_t* Qg = Q + ((size_t)(b * 4 + h) * NT + q0 + wid * 32 + r32) * 192 + hi * 8;
#pragma unroll
      for (int ds = 0; ds < 12; ++ds) qf[ds] = *(const bf16x8*)(Qg + ds * 16); }
    f32x16 o[4];
#pragma unroll
    for (int d = 0; d < 4; ++d)
#pragma unroll
        for (int r = 0; r < 16; ++r) o[d][r] = 0.f;
    float mrun = -1e30f, lrun = 0.f;
    u32x4 vr[2];
    const int vd0 = tid >> 3, vpart = tid & 7;
#define ALOAD(kt) do { const char* ks_ = Kg + (size_t)(kt) * AK_BYTES + tid * 16; \
        kr[0] = *(const u32x4*)(ks_); kr[1] = *(const u32x4*)(ks_ + 8192); kr[2] = *(const u32x4*)(ks_ + 16384); if (tid < 64) kr[3] = *(const u32x4*)(ks_ + 24576); \
        vr[0] = *(const u32x4*)(Vg + (size_t)vd0 * NT + (kt) * 64 + vpart * 8); vr[1] = *(const u32x4*)(Vg + (size_t)(vd0 + 64) * NT + (kt) * 64 + vpart * 8); } while (0)
#define ASTORE(buf) do { LAS unsigned char* kd_ = lds + (buf) * AK_BYTES + tid * 16; \
        *(LAS u32x4*)(kd_) = kr[0]; *(LAS u32x4*)(kd_ + 8192) = kr[1]; *(LAS u32x4*)(kd_ + 16384) = kr[2]; if (tid < 64) *(LAS u32x4*)(kd_ + 24576) = kr[3]; \
        LAS unsigned char* vd_ = lds + 2 * AK_BYTES + (buf) * AV_BYTES + vd0 * AV_PITCH + vpart * 16; \
        *(LAS u32x2*)(vd_) = (u32x2){vr[0].x, vr[0].y}; *(LAS u32x2*)(vd_ + 8) = (u32x2){vr[0].z, vr[0].w}; \
        *(LAS u32x2*)(vd_ + 64 * AV_PITCH) = (u32x2){vr[1].x, vr[1].y}; *(LAS u32x2*)(vd_ + 64 * AV_PITCH + 8) = (u32x2){vr[1].z, vr[1].w}; } while (0)
#define ALOADK(kt, buf) do { const char* ks_ = Kg + (size_t)(kt) * AK_BYTES + lane * 16; LAS unsigned char* kd_ = lds + (buf) * AK_BYTES; \
        _Pragma("unroll") for (int pj = 0; pj < 3; ++pj) __builtin_amdgcn_global_load_lds((const unsigned*)(ks_ + (wid + 8 * pj) * 1024), (LAS unsigned*)(kd_ + (wid + 8 * pj) * 1024), 16, 0, 0); \
        if (wid == 0) __builtin_amdgcn_global_load_lds((const unsigned*)(ks_ + 24 * 1024), (LAS unsigned*)(kd_ + 24 * 1024), 16, 0, 0); } while (0)
#define ALOADV(kt) do { vr[0] = *(const u32x4*)(Vg + (size_t)vd0 * NT + (kt) * 64 + vpart * 8); vr[1] = *(const u32x4*)(Vg + (size_t)(vd0 + 64) * NT + (kt) * 64 + vpart * 8); } while (0)
#define ASTOREV(buf) do { LAS unsigned char* vd_ = lds + 2 * AK_BYTES + (buf) * AV_BYTES + vd0 * AV_PITCH + vpart * 16; \
        *(LAS u32x2*)(vd_) = (u32x2){vr[0].x, vr[0].y}; *(LAS u32x2*)(vd_ + 8) = (u32x2){vr[0].z, vr[0].w}; \
        *(LAS u32x2*)(vd_ + 64 * AV_PITCH) = (u32x2){vr[1].x, vr[1].y}; *(LAS u32x2*)(vd_ + 64 * AV_PITCH + 8) = (u32x2){vr[1].z, vr[1].w}; } while (0)
    ALOADK(0, 0); ALOADV(0); ASTOREV(0);
    if (ntiles > 1) ALOADK(1, 1);
    asm volatile("s_waitcnt vmcnt(0)" ::: "memory");
    __syncthreads();
    f32x16 pc0, pc1;
    { const LAS unsigned char* kb = lds + r32 * (KP * 2) + hi * 16;
#pragma unroll
      for (int r = 0; r < 16; ++r) { pc0[r] = 0.f; pc1[r] = 0.f; }
#pragma unroll
      for (int ds = 0; ds < 12; ++ds) {
          const bf16x8 k0 = *(const LAS bf16x8*)(kb + ds * 32), k1 = *(const LAS bf16x8*)(kb + 32 * (KP * 2) + ds * 32);
          pc0 = __builtin_amdgcn_mfma_f32_32x32x16_bf16(k0, qf[ds], pc0, 0, 0, 0);
          pc1 = __builtin_amdgcn_mfma_f32_32x32x16_bf16(k1, qf[ds], pc1, 0, 0, 0); } }
    float mxc;
    { float mx = fmaxf(pc0[0], pc1[0]);
#pragma unroll
      for (int r = 1; r < 16; ++r) mx = fmaxf(mx, fmaxf(pc0[r], pc1[r]));
      mxc = fmaxf(mx, __shfl_xor(mx, 32)); }
    __syncthreads();
    for (int kt = 0; kt < ntiles; ++kt) {
        const int buf = kt & 1;
        if (kt + 2 < ntiles) ALOADK(kt + 2, buf);
        if (kt + 1 < ntiles) ALOADV(kt + 1);
        if (__any(mxc > mrun + 8.f)) {
            const float mnew = fmaxf(mrun, mxc), alpha = __builtin_amdgcn_exp2f(mrun - mnew);
            mrun = mnew; lrun *= alpha;
#pragma unroll
            for (int d = 0; d < 4; ++d)
#pragma unroll
                for (int r = 0; r < 16; ++r) o[d][r] *= alpha;
        }
        const LAS unsigned char* kb = lds + (buf ^ 1) * AK_BYTES + r32 * (KP * 2) + hi * 16;
        f32x16 pn0, pn1;
#pragma unroll
        for (int r = 0; r < 16; ++r) { pn0[r] = 0.f; pn1[r] = 0.f; }
        float ps = 0.f; u32x4 pw[4];
        bf16x8 ka = *(const LAS bf16x8*)(kb), kbb = *(const LAS bf16x8*)(kb + 32 * (KP * 2));
#pragma unroll
        for (int ds = 0; ds < 12; ++ds) {
            bf16x8 na = ka, nb = kbb;
            if (ds < 11) { na = *(const LAS bf16x8*)(kb + (ds + 1) * 32); nb = *(const LAS bf16x8*)(kb + 32 * (KP * 2) + (ds + 1) * 32); }
            pn0 = __builtin_amdgcn_mfma_f32_32x32x16_bf16(ka, qf[ds], pn0, 0, 0, 0);
            pn1 = __builtin_amdgcn_mfma_f32_32x32x16_bf16(kbb, qf[ds], pn1, 0, 0, 0);
            if (ds < 8) {
                float e[4];
#pragma unroll
                for (int j = 0; j < 4; ++j) { const float v = ds < 4 ? pc0[4 * ds + j] : pc1[4 * (ds - 4) + j]; e[j] = __builtin_amdgcn_exp2f(v - mrun); }
                ps += (e[0] + e[1]) + (e[2] + e[3]);
                const unsigned w0 = cvt_pk(e[0], e[1]), w1 = cvt_pk(e[2], e[3]);
                if ((ds & 1) == 0) { pw[ds >> 1].x = w0; pw[ds >> 1].y = w1; } else { pw[ds >> 1].z = w0; pw[ds >> 1].w = w1; }
            }
            ka = na; kbb = nb;
            __builtin_amdgcn_sched_barrier(0);
        }
        lrun += ps;
        const LAS unsigned char* vb = lds + 2 * AK_BYTES + buf * AV_BYTES + r32 * AV_PITCH + hi * 8;
#pragma unroll
        for (int d = 0; d < 4; ++d)
#pragma unroll
            for (int ks = 0; ks < 4; ++ks) {
                const s16x4 lo = *(const LAS s16x4*)(vb + d * 32 * AV_PITCH + ks * 32), hh = *(const LAS s16x4*)(vb + d * 32 * AV_PITCH + ks * 32 + 16);
                const bf16x8 vf = (bf16x8){lo[0], lo[1], lo[2], lo[3], hh[0], hh[1], hh[2], hh[3]};
                o[d] = __builtin_amdgcn_mfma_f32_32x32x16_bf16(vf, __builtin_bit_cast(bf16x8, pw[ks]), o[d], 0, 0, 0);
            }
        { float mx = fmaxf(pn0[0], pn1[0]);
#pragma unroll
          for (int r = 1; r < 16; ++r) mx = fmaxf(mx, fmaxf(pn0[r], pn1[r]));
          mxc = fmaxf(mx, __shfl_xor(mx, 32)); }
        if (kt + 1 < ntiles) ASTOREV(buf ^ 1);
        asm volatile("s_waitcnt vmcnt(0)" ::: "memory");
        __syncthreads();
        pc0 = pn0; pc1 = pn1;
    }
#undef ALOADK
#undef ALOADV
#undef ASTOREV
#undef ALOAD
#undef ASTORE
    const float inv = 1.f / (lrun + __shfl_xor(lrun, 32));
    bf16_t* op = cat + ((size_t)b * NT + q0 + wid * 32 + r32) * DM + h * 128 + 4 * hi;
#pragma unroll
    for (int d = 0; d < 4; ++d)
#pragma unroll
        for (int gq = 0; gq < 4; ++gq) { u32x2 w; w.x = cvt_pk(o[d][4 * gq] * inv, o[d][4 * gq + 1] * inv); w.y = cvt_pk(o[d][4 * gq + 2] * inv, o[d][4 * gq + 3] * inv); *(u32x2*)(op + d * 32 + gq * 8) = w; }
}

__device__ __forceinline__ int scan_row(int b, int dir, int s) { if (s < TC) return b * NT + TL + (dir ? TC - 1 - s : s); const int li = s - TC; return b * NT + (dir ? TL - 1 - li : li); }
constexpr int S_QT = 0, S_QH = 17408, S_KD = 34816, S_KX = 52224, S_K4T = 78336, S_VT = 96768, S_ST = 105984, S_P = 123392, S_TOT = 132608, S_TS = 133120, S_LB = 137216;
__device__ __forceinline__ void scan_job(LAS unsigned char* lds, int b, int h, int dir, int layer, const bf16_t* P, const float* lbp, bf16_t* xc, bf16_t* ob) {
    int tid = threadIdx.x; asm volatile("" : "+v"(tid));
    const int lane = tid & 63; const int wid = __builtin_amdgcn_readfirstlane(tid >> 6);
    const int kp = tid & 63, g = wid, si = g >> 1;
    const int l15 = lane & 15, lq = lane >> 4;
    LAS float* TOT = (LAS float*)(lds + S_TOT); LAS float* TS = (LAS float*)(lds + S_TS); LAS float* LB = (LAS float*)(lds + S_LB);
    __syncthreads();
    if (tid < 128) { float lb = 0.f; if (layer == 1) { const float a0 = lbp[(0 * 2 + dir) * 512 + h * 128 + tid], a1 = lbp[(1 * 2 + dir) * 512 + h * 128 + tid]; lb = 1.f / (1.f + __expf(a0 - a1)); } LB[tid] = lb; }
    for (int i = tid; i < (17408 + 9216) / 16; i += 512) { const int off = i < 1088 ? S_ST + i * 16 : S_P + (i - 1088) * 16; *(LAS u32x4*)(lds + off) = (u32x4){0u, 0u, 0u, 0u}; }
    const int zoff = dir ? O_HFB : O_HFF; const long rstep = dir ? -(long)INP : (long)INP;
    f32x4 Sacc[4];
#pragma unroll
    for (int j = 0; j < 4; ++j) Sacc[j] = (f32x4){0.f, 0.f, 0.f, 0.f};
    unsigned q2[8], z2[8]; u32x2 vra, vrb;
#define CLOAD(ch) do { const bf16_t* pr_ = P + (size_t)scan_row(b, dir, (ch) * 64 + g * 8) * INP + h * 128 + 2 * kp; \
        _Pragma("unroll") for (int tt = 0; tt < 8; ++tt) { q2[tt] = *(const unsigned*)(pr_ + O_HQ); z2[tt] = *(const unsigned*)(pr_ + zoff); pr_ += rstep; } \
        vra = *(const u32x2*)(P + (size_t)scan_row(b, dir, (ch) * 64 + 2 * (tid >> 4)) * INP + O_HI + h * 64 + (tid & 15) * 4); \
        vrb = *(const u32x2*)(P + (size_t)scan_row(b, dir, (ch) * 64 + 2 * (tid >> 4) + 1) * INP + O_HI + h * 64 + (tid & 15) * 4); } while (0)
    CLOAD(0);
    __syncthreads();
    const float lb0 = LB[2 * kp], lb1 = LB[2 * kp + 1];
    for (int ch = 0; ch < NT / 64; ++ch) {
        float qv[2][8], kk[2][8], pf[2][8];
#pragma unroll
        for (int c = 0; c < 2; ++c) { float run = 1.f; const float lb = c ? lb1 : lb0;
#pragma unroll
            for (int tt = 0; tt < 8; ++tt) { const float xq = c ? bfhi(q2[tt]) : bflo(q2[tt]), xz = c ? bfhi(z2[tt]) : bflo(z2[tt]);
                qv[c][tt] = xq * __builtin_amdgcn_rcpf(1.f + __builtin_amdgcn_exp2f(-1.4426950408889634f * xq));
                const float f = lb + (1.f - lb) * __builtin_amdgcn_rcpf(1.f + __builtin_amdgcn_exp2f(-1.4426950408889634f * xz));
                kk[c][tt] = 1.f - f; run = fmaxf(run * f, 7.888609052210118e-31f); pf[c][tt] = run; }
            TS[g * 128 + 2 * kp + c] = __builtin_amdgcn_logf(run); }
        { const int s2 = 2 * (tid >> 4), v4 = (tid & 15) * 4; LAS unsigned* vt = (LAS unsigned*)(lds + S_VT + v4 * 144 + s2 * 2);
          vt[0] = (vra.x & 0xffffu) | (vrb.x << 16); vt[36] = (vra.x >> 16) | (vrb.x & 0xffff0000u); vt[72] = (vra.y & 0xffffu) | (vrb.y << 16); vt[108] = (vra.y >> 16) | (vrb.y & 0xffff0000u); }
        __syncthreads();
        if (ch + 1 < NT / 64) CLOAD(ch + 1);
        { float qa[2][8], ka[2][8], eBv[2], e1v[2], e2v[2], e3v[2], eTv[2];
          typedef float f32x2_ __attribute__((ext_vector_type(2))); f32x2_ tsv[8];
#pragma unroll
          for (int j = 0; j < 8; ++j) tsv[j] = *(const LAS f32x2_*)(TS + j * 128 + 2 * kp);
#pragma unroll
          for (int c = 0; c < 2; ++c) { const int k = 2 * kp + c; float Bg[9]; Bg[0] = 0.f;
#pragma unroll
              for (int j = 0; j < 8; ++j) Bg[j + 1] = Bg[j] + (c ? tsv[j].y : tsv[j].x);
              const float Bi = si == 0 ? Bg[0] : (si == 1 ? Bg[2] : (si == 2 ? Bg[4] : Bg[6]));
              const float Bgg = (g & 1) ? (si == 0 ? Bg[1] : (si == 1 ? Bg[3] : (si == 2 ? Bg[5] : Bg[7]))) : Bi;
              const float eoc = __builtin_amdgcn_exp2f(Bgg - Bi);
              eBv[c] = __builtin_amdgcn_exp2f(Bi); e1v[c] = __builtin_amdgcn_exp2f(Bg[2] - Bi); e2v[c] = __builtin_amdgcn_exp2f(Bg[4] - Bi); e3v[c] = __builtin_amdgcn_exp2f(Bg[6] - Bi); eTv[c] = __builtin_amdgcn_exp2f(Bg[8] - Bi);
              if (g == 0) TOT[k] = __builtin_amdgcn_exp2f(Bg[8]);
#pragma unroll
              for (int tt = 0; tt < 8; ++tt) { const float pfu = fmaxf(pf[c][tt] * eoc, 7.888609052210118e-31f); qa[c][tt] = qv[c][tt] * pfu; ka[c][tt] = kk[c][tt] * __builtin_amdgcn_rcpf(pfu); } }
          LAS unsigned* qt = (LAS unsigned*)(lds + S_QT + (8 * g) * 272 + 4 * kp); LAS unsigned* qh = (LAS unsigned*)(lds + S_QH + (8 * g) * 272 + 4 * kp);
          LAS unsigned* kd = (LAS unsigned*)(lds + S_KD + (8 * g) * 272 + 4 * kp); LAS unsigned* kx = (LAS unsigned*)(lds + S_KX + (8 * g) * 272 + 4 * kp);
          unsigned k4[2][4];
#pragma unroll
          for (int tt = 0; tt < 8; ++tt) {
              qt[tt * 68] = cvt_pk(qa[0][tt], qa[1][tt]); qh[tt * 68] = cvt_pk(qa[0][tt] * eBv[0], qa[1][tt] * eBv[1]); kd[tt * 68] = cvt_pk(ka[0][tt], ka[1][tt]);
              if (si < 1) kx[tt * 68] = cvt_pk(ka[0][tt] * e1v[0], ka[1][tt] * e1v[1]);
              if (si < 2) kx[(16 + tt) * 68] = cvt_pk(ka[0][tt] * e2v[0], ka[1][tt] * e2v[1]);
              if (si < 3) kx[(48 + tt) * 68] = cvt_pk(ka[0][tt] * e3v[0], ka[1][tt] * e3v[1]); }
#pragma unroll
          for (int c = 0; c < 2; ++c) {
#pragma unroll
              for (int t2 = 0; t2 < 4; ++t2) k4[c][t2] = cvt_pk(ka[c][2 * t2] * eTv[c], ka[c][2 * t2 + 1] * eTv[c]);
              *(LAS u32x4*)(lds + S_K4T + (2 * kp + c) * 144 + g * 16) = (u32x4){k4[c][0], k4[c][1], k4[c][2], k4[c][3]}; } }
        __syncthreads();
        for (int bl = wid; bl < 10; bl += 8) { const int bi = bl >= 6 ? 3 : (bl >= 3 ? 2 : (bl >= 1 ? 1 : 0)), bj = bl - (bi * (bi + 1)) / 2;
            const LAS unsigned char* ap = lds + S_QT + (16 * bi + l15) * 272 + lq * 16;
            const int krow = bi == bj ? 16 * bi : (bi == 1 ? 0 : (bi == 2 ? 16 : 48)) + 16 * bj;
            const LAS unsigned char* bp = lds + (bi == bj ? S_KD : S_KX) + (krow + l15) * 272 + lq * 16;
            f32x4 sc = (f32x4){0.f, 0.f, 0.f, 0.f};
#pragma unroll
            for (int ks = 0; ks < 4; ++ks) sc = __builtin_amdgcn_mfma_f32_16x16x32_bf16(*(const LAS bf16x8*)(ap + ks * 64), *(const LAS bf16x8*)(bp + ks * 64), sc, 0, 0, 0);
            LAS bf16_t* pp = (LAS bf16_t*)(lds + S_P) + (16 * bi + 4 * lq) * 72 + 16 * bj + l15;
#pragma unroll
            for (int r = 0; r < 4; ++r) { float v = sc[r]; if (bi == bj && l15 > 4 * lq + r) v = 0.f; pp[r * 72] = (bf16_t)f2bf(v); } }
        __syncthreads();
        { const int ti = wid >> 1, vj0 = 2 * (wid & 1);
          const LAS unsigned char* pa = lds + S_P + (16 * ti + l15) * 144 + lq * 16; const LAS unsigned char* qa = lds + S_QH + (16 * ti + l15) * 272 + lq * 16;
          const bf16x8 a0 = *(const LAS bf16x8*)(pa), a1 = *(const LAS bf16x8*)(pa + 64);
          const bf16x8 q0 = *(const LAS bf16x8*)(qa), q1 = *(const LAS bf16x8*)(qa + 64), q2 = *(const LAS bf16x8*)(qa + 128), q3 = *(const LAS bf16x8*)(qa + 192);
          const size_t row0 = (size_t)scan_row(b, dir, ch * 64 + 16 * ti + 4 * lq);
#pragma unroll
          for (int vv = 0; vv < 2; ++vv) { const int vj = vj0 + vv;
              const LAS unsigned char* vb = lds + S_VT + (16 * vj + l15) * 144 + lq * 16; const LAS unsigned char* sb = lds + S_ST + (16 * vj + l15) * 272 + lq * 16;
              f32x4 o = (f32x4){0.f, 0.f, 0.f, 0.f};
              o = __builtin_amdgcn_mfma_f32_16x16x32_bf16(a0, *(const LAS bf16x8*)(vb), o, 0, 0, 0);
              o = __builtin_amdgcn_mfma_f32_16x16x32_bf16(a1, *(const LAS bf16x8*)(vb + 64), o, 0, 0, 0);
              o = __builtin_amdgcn_mfma_f32_16x16x32_bf16(q0, *(const LAS bf16x8*)(sb), o, 0, 0, 0);
              o = __builtin_amdgcn_mfma_f32_16x16x32_bf16(q1, *(const LAS bf16x8*)(sb + 64), o, 0, 0, 0);
              o = __builtin_amdgcn_mfma_f32_16x16x32_bf16(q2, *(const LAS bf16x8*)(sb + 128), o, 0, 0, 0);
              o = __builtin_amdgcn_mfma_f32_16x16x32_bf16(q3, *(const LAS bf16x8*)(sb + 192), o, 0, 0, 0);
              const int col = h * 64 + 16 * vj + l15;
#pragma unroll
              for (int r = 0; r < 4; ++r) { const size_t row = dir ? row0 - r : row0 + r;
                  if (dir == 0) xc[row * DM + 512 + col] = (bf16_t)f2bf(o[r]); else ob[row * 256 + col] = (bf16_t)f2bf(o[r]); } } }
        { const f32x4 dec = *(const LAS f32x4*)(TOT + 16 * wid + 4 * lq);
          const LAS unsigned char* ka = lds + S_K4T + (16 * wid + l15) * 144 + lq * 16; const bf16x8 k0 = *(const LAS bf16x8*)(ka), k1 = *(const LAS bf16x8*)(ka + 64);
#pragma unroll
          for (int vj = 0; vj < 4; ++vj) { const LAS unsigned char* vb = lds + S_VT + (16 * vj + l15) * 144 + lq * 16;
              f32x4 a = Sacc[vj] * dec;
              a = __builtin_amdgcn_mfma_f32_16x16x32_bf16(k0, *(const LAS bf16x8*)(vb), a, 0, 0, 0);
              a = __builtin_amdgcn_mfma_f32_16x16x32_bf16(k1, *(const LAS bf16x8*)(vb + 64), a, 0, 0, 0);
              Sacc[vj] = a; } }
        __syncthreads();
#pragma unroll
        for (int vj = 0; vj < 4; ++vj) { u32x2 w; w.x = cvt_pk(Sacc[vj][0], Sacc[vj][1]); w.y = cvt_pk(Sacc[vj][2], Sacc[vj][3]);
            *(LAS u32x2*)(lds + S_ST + (16 * vj + l15) * 272 + (16 * wid + 4 * lq) * 2) = w; }
    }
#undef CLOAD
    __syncthreads();
}


#define XB_TMO      128
#define XB_XCNT(j)  (256  + 64 * (j))
#define XB_XSUB(j)  (1280 + 64 * (j))
#define XB_XGEN(j)  (2304 + 64 * (j))
#define XB_TOP      3328
#define XB_TOPGEN   3392
#define XCD_BAR_WORDS 3456
#define XB_SPIN_CAP (1u << 18)
__device__ __forceinline__ unsigned xb_ld(unsigned* p)              { return __hip_atomic_load(p, __ATOMIC_RELAXED, __HIP_MEMORY_SCOPE_AGENT); }
__device__ __forceinline__ unsigned xb_add(unsigned* p, unsigned v) { return __hip_atomic_fetch_add(p, v, __ATOMIC_RELAXED, __HIP_MEMORY_SCOPE_AGENT); }
__device__ __forceinline__ unsigned xb_xcc_id() { return (unsigned)__builtin_amdgcn_s_getreg((3 << 11) | 20) & 0xFu; }
#define XB_SPIN(cond, bar) do { unsigned _sp = 0; while (cond) { __builtin_amdgcn_s_sleep(1); \
    if ((++_sp & 255u) == 0u) { if (xb_ld(&(bar)[XB_TMO])) break; if (_sp > XB_SPIN_CAP) { atomicAdd(&(bar)[XB_TMO], 1u); break; } } } } while (0)
struct XcdBarrier { unsigned* bar; unsigned x; volatile LAS unsigned* st; };
__device__ __forceinline__ XcdBarrier xcd_barrier_post(unsigned* bar, volatile LAS unsigned* st) {
    XcdBarrier b; b.bar = bar; b.x = xb_xcc_id(); b.st = st;
    if (threadIdx.x == 0) (void)xb_add(&bar[XB_XCNT(b.x)], 1u);
    return b;
}
__device__ __forceinline__ void xcd_barrier_complete(unsigned* bar, unsigned x, unsigned& nloc, unsigned& nx) {
    const unsigned G = gridDim.x * gridDim.y * gridDim.z;
    unsigned sum, cnt, mine, sp = 0u;
    for (;;) {
        sum = 0u; cnt = 0u; mine = 0u;
#pragma unroll
        for (unsigned j = 0; j < 16; ++j) { const unsigned c = xb_ld(&bar[XB_XCNT(j)]); sum += c; cnt += (c > 0u) ? 1u : 0u; mine = (j == x) ? c : mine; }
        if (sum == G) break;
        __builtin_amdgcn_s_sleep(1);
        if ((++sp & 255u) == 0u) { if (xb_ld(&bar[XB_TMO])) break; if (sp > XB_SPIN_CAP) { atomicAdd(&bar[XB_TMO], 1u); break; } }
    }
    nloc = mine > 0u ? mine : 1u; nx = cnt > 0u ? cnt : 1u;
}
__device__ __forceinline__ void xcd_barrier(const XcdBarrier& b) {
    asm volatile("s_waitcnt vmcnt(0)" ::: "memory");
    __syncthreads();
    if (threadIdx.x == 0) {
        unsigned* bar = b.bar;
        __builtin_amdgcn_s_waitcnt(0);
        unsigned nloc = b.st[0], nx = b.st[1];
        if (nloc == 0u) { xcd_barrier_complete(bar, b.x, nloc, nx); b.st[0] = nloc; b.st[1] = nx; }
        const unsigned old = xb_add(&bar[XB_XSUB(b.x)], 1u);
        const unsigned gen = old / nloc;
        if (old + 1u == (gen + 1u) * nloc) {
            __builtin_amdgcn_fence(__ATOMIC_RELEASE, "agent");
            asm volatile("s_waitcnt vmcnt(0)" ::: "memory");
            const unsigned og = xb_add(&bar[XB_TOP], 1u);
            const unsigned tg = og / nx;
            if (og + 1u == (tg + 1u) * nx) xb_add(&bar[XB_TOPGEN], 1u);
            else XB_SPIN(xb_ld(&bar[XB_TOPGEN]) == tg, bar);
            __builtin_amdgcn_fence(__ATOMIC_ACQUIRE, "agent");
            xb_add(&bar[XB_XGEN(b.x)], 1u);
            asm volatile("s_waitcnt vmcnt(0)" ::: "memory");
        } else {
            XB_SPIN(xb_ld(&bar[XB_XGEN(b.x)]) == gen, bar);
            __builtin_amdgcn_fence(__ATOMIC_ACQUIRE, "agent");
            asm volatile("s_waitcnt vmcnt(0)" ::: "memory");
        }
    }
    __syncthreads();
}
constexpr int LDS_BARST = 147456 - 64;

struct Args { const float* in[20]; float* out; unsigned char* ws; int ph_lo, ph_hi; };

__device__ __forceinline__ void transpose_item(const float* W, int ldw, int k0, int n0, bf16_t* WT, int ldt, int drow0, LAS float* scr, int lane) {
#pragma unroll 16
    for (int i = 0; i < 32; ++i) { const int kk = 2 * i + (lane >> 5); scr[kk * 33 + (lane & 31)] = W[(size_t)(k0 + kk) * ldw + n0 + (lane & 31)]; }
    asm volatile("s_waitcnt lgkmcnt(0)" ::: "memory");
    const int c = lane & 7;
#pragma unroll
    for (int j = 0; j < 4; ++j) { const int n = (lane >> 3) + 8 * j; const LAS float* s = scr + (8 * c) * 33 + n;
        u32x4 o; o.x = f2bf(s[0]) | (f2bf(s[33]) << 16); o.y = f2bf(s[66]) | (f2bf(s[99]) << 16); o.z = f2bf(s[132]) | (f2bf(s[165]) << 16); o.w = f2bf(s[198]) | (f2bf(s[231]) << 16);
        *(u32x4*)(WT + (size_t)(drow0 + n) * ldt + k0 + 8 * c) = o; }
    asm volatile("s_waitcnt lgkmcnt(0)" ::: "memory");
}

template <int PH> __device__ __forceinline__ void phase_body(const Args& args, LAS unsigned char* lds) {
    const int G = gridDim.x, bx = blockIdx.x;
    const int vcu = (G % 8 == 0) ? (bx % 8) * (G / 8) + bx / 8 : bx;
    unsigned char* ws = args.ws;
    const float* x_in = args.in[0]; const float* c_in = args.in[1]; const float* ctx_in = args.in[2]; const float* cctx = args.in[3];
    const float* w_mod = args.in[4]; const float* b_mod = args.in[5]; const float* n1g = args.in[6]; const float* n2g = args.in[7]; const float* w_in = args.in[8];
    const float* qng = args.in[9]; const float* w_uq = args.in[10]; const float* kvng = args.in[11]; const float* w_ukv = args.in[12]; const float* lbp = args.in[13];
    const float* hgg = args.in[14]; const float* w_fou = args.in[15]; const float* w_out = args.in[16]; const float* w_gu = args.in[17]; const float* w_dn = args.in[18]; const float* fng = args.in[19];
    float* out = args.out;
    bf16_t* WIN = (bf16_t*)(ws + W_WIN); bf16_t* WGU = (bf16_t*)(ws + W_WGU); bf16_t* WDN = (bf16_t*)(ws + W_WDN); bf16_t* WOUT = (bf16_t*)(ws + W_WOUT);
    bf16_t* WS = (bf16_t*)(ws + W_WS);
    bf16_t* DMAT = (bf16_t*)(ws + W_DM); bf16_t* DCM = (bf16_t*)(ws + W_DC); float* COST = (float*)(ws + W_COS); float* SINT = (float*)(ws + W_SIN);
    float* MOD = (float*)(ws + W_MOD); float* STAT = (float*)(ws + W_STAT); bf16_t* OB = (bf16_t*)(ws + W_OB); bf16_t* ZC = (bf16_t*)(ws + W_ZC); bf16_t* ZCC = (bf16_t*)(ws + W_ZCC);
    bf16_t* VT = (bf16_t*)(ws + W_VT); bf16_t* KB = (bf16_t*)(ws + W_K); bf16_t* QB = (bf16_t*)(ws + W_Q); bf16_t* XR = (bf16_t*)args.out;
    bf16_t* XC = (bf16_t*)(ws + W_XC); bf16_t* PB = (bf16_t*)(ws + W_P);

        int tid = threadIdx.x; asm volatile("" : "+v"(tid));
        const int lane = tid & 63; const int wave = __builtin_amdgcn_readfirstlane(tid >> 6);
        const int gw = bx * 8 + wave, NGW = G * 8; const int gt = bx * 512 + tid, NGT = G * 512;
        if constexpr (PH == 0) { if (EN(0)) REP(8) {
            LAS float* scr = (LAS float*)(lds + wave * 8704);
            { constexpr int I_IN = 16 * 86, I_GU = 16 * 176, I_DN = 44 * 32, I_OUT = 12 * 32, PERL = I_IN + I_GU + I_DN + I_OUT;
              for (int it = gw; it < 2 * PERL; it += NGW) { const int l = it / PERL; int r = it - l * PERL;
                  if (r < I_IN) { const int kb = r / 86, nb = r % 86; transpose_item(w_in + (size_t)l * DM * INW, INW, kb * 64, nb * 32, WIN + (size_t)l * INP * DM, DM, nb * 32, scr, lane); continue; } r -= I_IN;
                  if (r < I_GU) { const int kb = r / 176, nb = r % 176; const int n0 = nb * 32, half = n0 >= FF ? 1 : 0, j0 = n0 - half * FF;
                      transpose_item(w_gu + (size_t)l * DM * 5632, 5632, kb * 64, n0, WGU + (size_t)l * 5632 * DM, DM, 256 * (j0 / 128) + half * 128 + (j0 % 128), scr, lane); continue; } r -= I_GU;
                  if (r < I_DN) { const int kb = r / 32, nb = r % 32; transpose_item(w_dn + (size_t)l * FF * DM, DM, kb * 64, nb * 32, WDN + (size_t)l * DM * FF, FF, nb * 32, scr, lane); continue; } r -= I_DN;
                  { const int kb = r / 32, nb = r % 32; transpose_item(w_out + (size_t)l * DM * DM, DM, kb * 64, nb * 32, WOUT + (size_t)l * DM * DM, DM, nb * 32, scr, lane); } } }
            for (int i = gt; i < 2 * 64 * DM / 8; i += NGT) { const int l = i / (64 * DM / 8), r = i % (64 * DM / 8); *(u32x4*)(WIN + (size_t)l * INP * DM + (size_t)INW * DM + r * 8) = (u32x4){0u, 0u, 0u, 0u}; }
            for (int i = gt; i < 2 * 256 * 768; i += NGT) { const int l = i / (256 * 768), r = i % (256 * 768), k = r / 768, n = r % 768;
                WS[(size_t)n * INP + l * 1024 + k] = (bf16_t)f2bf(w_uq[(size_t)l * 256 * 768 + k * 768 + n] * qng[l * 256 + k]);
                const int h = n / 192, d = n % 192; float v;
                if (d < 128) v = k < 128 ? w_ukv[(size_t)l * 128 * 1024 + k * 1024 + h * 256 + d] * kvng[l * 128 + k] : 0.f; else v = (k == d) ? 1.f : 0.f;
                WS[(size_t)n * INP + l * 1024 + 256 + k] = (bf16_t)f2bf(v); }
            for (int i = gt; i < 2 * 256 * 512; i += NGT) { const int l = i / (256 * 512), r = i % (256 * 512), k = r / 512, n = r % 512; const int h = n / 128, d = n % 128;
                const float v = k < 128 ? w_ukv[(size_t)l * 128 * 1024 + k * 1024 + h * 256 + 128 + d] * kvng[l * 128 + k] : 0.f;
                WS[(size_t)n * INP + l * 1024 + 512 + k] = (bf16_t)f2bf(v); }
            for (int i = gt; i < 2 * 256 * 1024; i += NGT) { const int l = i / (256 * 1024), r = i % (256 * 1024), kp = r / 1024, n = r % 1024;
                const float* wf = w_fou + (size_t)l * 256 * 256 + kp * 256; const float* wo = w_out + (size_t)l * DM * DM + (size_t)768 * DM + n; float s = 0.f;
                for (int j = 0; j < 256; ++j) s = fmaf(wf[j], wo[(size_t)j * DM], s);
                WOUT[(size_t)l * DM * DM + (size_t)n * DM + 768 + kp] = (bf16_t)f2bf(s); }
            for (int i = gt; i < 512 * 256; i += NGT) { const int m = i / 256, k = i % 256, np = m >> 1, which = m & 1; float v = 0.f;
                if ((np >> 6) == (k >> 6)) { const int mm = ((np & 63) * (k & 63)) & 63; v = (which ? sinpif((float)mm * (1.f / 32.f)) : cospif((float)mm * (1.f / 32.f))) * 0.125f; }
                WS[(size_t)m * INP + 2048 + k] = (bf16_t)f2bf(v); }
            for (int i = gt; i < TL * TL; i += NGT) { const int tp = i / TL, t = i % TL; const float a = (float)((tp * t) & (TL - 1)) * (1.f / 1024.f);
                DMAT[(size_t)tp * 4096 + t] = (bf16_t)f2bf(cospif(a) * 0.022097086912079608f); DMAT[(size_t)tp * 4096 + TL + t] = (bf16_t)f2bf(-sinpif(a) * 0.022097086912079608f); }
            for (int i = gt; i < TC * TC; i += NGT) { const int tp = i / TC, t = i % TC; const float a = (float)((tp * t) & (TC - 1)) * (1.f / 128.f);
                DCM[tp * 512 + t] = (bf16_t)f2bf(cospif(a) * 0.0625f); DCM[tp * 512 + TC + t] = (bf16_t)f2bf(-sinpif(a) * 0.0625f); }
            for (int i = gt; i < TL * 32; i += NGT) { const int t = i / 32, jj = i % 32, j = jj & 15; const float pos = (float)(jj < 16 ? (t >> 6) : (t & 63));
                const float ang = pos * powf(10000.f, -(float)(2 * j) / 32.f); COST[i] = cosf(ang); SINT[i] = sinf(ang); }
            __syncthreads();
            for (int it = bx; it < 2 * 96; it += G) { const int l = it / 96, n = (it % 96) * 64 + lane; const float* wm = w_mod + (size_t)l * DM * 6144 + n;
                float acc[33];
#pragma unroll
                for (int m = 0; m < 33; ++m) acc[m] = 0.f;
                LAS float* sa = (LAS float*)lds;
#pragma nounroll
                for (int kh = 0; kh < 2; ++kh) {
                    __syncthreads();
#pragma unroll
                    for (int mb_ = 0; mb_ < 2; ++mb_) { float cv[16];
#pragma unroll
                      for (int m = 0; m < 16; ++m) cv[m] = c_in[(mb_ * 16 + m) * DM + kh * 512 + tid];
#pragma unroll
                      for (int m4 = 0; m4 < 4; ++m4) *(LAS f32x4*)(sa + tid * 36 + mb_ * 16 + m4 * 4) = (f32x4){silu_f(cv[m4 * 4]), silu_f(cv[m4 * 4 + 1]), silu_f(cv[m4 * 4 + 2]), silu_f(cv[m4 * 4 + 3])}; }
                    sa[tid * 36 + 32] = silu_f(cctx[kh * 512 + tid]);
                    __syncthreads();
                    for (int kk0 = 0; kk0 < 64; kk0 += 16) { float wv[16];
#pragma unroll
                        for (int u = 0; u < 16; ++u) wv[u] = wm[(size_t)(kh * 512 + wave * 64 + kk0 + u) * 6144];
#pragma unroll
                        for (int u = 0; u < 16; ++u) { const float w = wv[u]; const LAS float* sp = sa + (wave * 64 + kk0 + u) * 36;
#pragma unroll
                            for (int m4 = 0; m4 < 8; ++m4) { const f32x4 s4 = *(const LAS f32x4*)(sp + m4 * 4);
#pragma unroll
                                for (int i = 0; i < 4; ++i) acc[m4 * 4 + i] = fmaf(s4[i], w, acc[m4 * 4 + i]); }
                            acc[32] = fmaf(sp[32], w, acc[32]); } }
                }
                __syncthreads();
                LAS float* red = (LAS float*)lds;
#pragma unroll
                for (int m = 0; m < 33; ++m) red[(wave * 33 + m) * 64 + lane] = acc[m];
                __syncthreads();
                for (int i = tid; i < 33 * 64; i += 512) { const int m = i / 64, nn = i % 64; float s = 0.f;
#pragma unroll
                    for (int w = 0; w < 8; ++w) s += red[(w * 33 + m) * 64 + nn];
                    const int ncol = (it % 96) * 64 + nn; MOD[((size_t)l * 33 + m) * 6144 + ncol] = s + b_mod[l * 6144 + ncol]; }
                __syncthreads();
            }
        } } else if constexpr (PH == NPHASE - 1) { if (EN(9)) {
            for (int R = 4 * gw; R < NB * TL; R += 4 * NGW) { const int b = R / TL, n = R - b * TL; const bf16_t* xs = XC + ((size_t)b * NT + n) * DM + lane * 4; float* xr = out + (size_t)R * DM + lane * 4;
                u32x2 q[4][4]; float rr[4];
#pragma unroll
                for (int rw = 0; rw < 4; ++rw)
#pragma unroll
                    for (int j = 0; j < 4; ++j) q[rw][j] = *(const u32x2*)(xs + (size_t)rw * DM + 256 * j);
#pragma unroll
                for (int rw = 0; rw < 4; ++rw) { float s_ = 0.f;
#pragma unroll
                    for (int j = 0; j < 4; ++j) { const float a0 = bflo(q[rw][j].x), a1 = bfhi(q[rw][j].x), a2 = bflo(q[rw][j].y), a3 = bfhi(q[rw][j].y); s_ += (a0 * a0 + a1 * a1) + (a2 * a2 + a3 * a3); }
                    rr[rw] = rsqrtf(wave_sum(s_) * (1.f / DM) + EPS); }
#pragma unroll
                for (int j = 0; j < 4; ++j) { const f32x4 g4 = *(const f32x4*)(fng + lane * 4 + 256 * j);
#pragma unroll
                    for (int rw = 0; rw < 4; ++rw) { const f32x4 v = (f32x4){bflo(q[rw][j].x), bfhi(q[rw][j].x), bflo(q[rw][j].y), bfhi(q[rw][j].y)};
                        __builtin_nontemporal_store(v * rr[rw] * g4, (f32x4*)(xr + (size_t)rw * DM + 256 * j)); } } }
        } } else {
            constexpr int l = (PH - 1) >> 3, sub = (PH - 1) & 7;
            const float* modl = MOD + (size_t)l * 33 * 6144;
            if ((sub == 0 || sub == 5) && EN(1)) {
                const float* srcL = x_in; const float* srcC = ctx_in;
                const float* gain = (sub == 0 ? n1g : n2g) + l * DM; const int shoff = sub == 0 ? 0 : 3072, scoff = shoff + 1024;
                if (sub == 0 && l == 0) {
                REP(4) for (int R = 4 * gw; R < MR; R += 4 * NGW) { const int b = R / NT, n = R - b * NT; const bool isc = n >= TL;
                    const float* xr = (isc ? srcC + ((size_t)b * TC + n - TL) * DM : srcL + ((size_t)b * TL + n) * DM) + lane * 4; const float* mp = modl + (isc ? 32 : b) * 6144 + lane * 4;
                    f32x4 v[4][4]; float rr[4];
#pragma unroll
                    for (int rw = 0; rw < 4; ++rw)
#pragma unroll
                        for (int j = 0; j < 4; ++j) v[rw][j] = __builtin_nontemporal_load((const f32x4*)(xr + (size_t)rw * DM + 256 * j));
#pragma unroll
                    for (int rw = 0; rw < 4; ++rw) { float s_ = 0.f;
#pragma unroll
                        for (int j = 0; j < 4; ++j) s_ += (v[rw][j][0] * v[rw][j][0] + v[rw][j][1] * v[rw][j][1]) + (v[rw][j][2] * v[rw][j][2] + v[rw][j][3] * v[rw][j][3]);
                        rr[rw] = rsqrtf(wave_sum(s_) * (1.f / DM) + EPS); }
#pragma unroll
                    for (int j = 0; j < 4; ++j) { const f32x4 g4 = *(const f32x4*)(gain + lane * 4 + 256 * j), sc = *(const f32x4*)(mp + scoff + 256 * j) + 1.f, sh = *(const f32x4*)(mp + shoff + 256 * j);
#pragma unroll
                        for (int rw = 0; rw < 4; ++rw) { const f32x4 y = (v[rw][j] * rr[rw] * g4) * sc + sh; u32x2 w; w.x = cvt_pk(y[0], y[1]); w.y = cvt_pk(y[2], y[3]); *(u32x2*)(XC + (size_t)(R + rw) * DM + lane * 4 + 256 * j) = w; } } }
                } else {
                    for (int R = 4 * gw; R < MR; R += 4 * NGW) { const int b = R / NT, n = R - b * NT; const bool isc = n >= TL;
                        if (isc && sub == 5 && l == 1) continue;
                        const bf16_t* xr = XR + (size_t)R * DM + lane * 4; const float* mp = modl + (isc ? 32 : b) * 6144 + lane * 4;
                        u32x2 q[4][4]; float ss[4];
#pragma unroll
                        for (int rw = 0; rw < 4; ++rw)
#pragma unroll
                            for (int j = 0; j < 4; ++j) q[rw][j] = *(const u32x2*)(xr + (size_t)rw * DM + 256 * j);
#pragma unroll
                        for (int rw = 0; rw < 4; ++rw) { float s_ = 0.f;
#pragma unroll
                            for (int j = 0; j < 4; ++j) { const float a0 = bflo(q[rw][j].x), a1 = bfhi(q[rw][j].x), a2 = bflo(q[rw][j].y), a3 = bfhi(q[rw][j].y); s_ += (a0 * a0 + a1 * a1) + (a2 * a2 + a3 * a3); }
                            ss[rw] = rsqrtf(wave_sum(s_) * (1.f / DM) + EPS); }
#pragma unroll
                        for (int j = 0; j < 4; ++j) { const f32x4 g4 = *(const f32x4*)(gain + lane * 4 + 256 * j), sc = *(const f32x4*)(mp + scoff + 256 * j) + 1.f, sh = *(const f32x4*)(mp + shoff + 256 * j); const f32x4 gs = g4 * sc;
#pragma unroll
                            for (int rw = 0; rw < 4; ++rw) { const f32x4 v = (f32x4){bflo(q[rw][j].x), bfhi(q[rw][j].x), bflo(q[rw][j].y), bfhi(q[rw][j].y)}; const f32x4 y = (v * ss[rw]) * gs + sh; u32x2 w;
                                w.x = cvt_pk(y[0], y[1]); w.y = cvt_pk(y[2], y[3]); *(u32x2*)(XC + (size_t)(R + rw) * DM + lane * 4 + 256 * j) = w; } } }
                }
            } else if (sub == 1 && EN(2)) {
                pg8::Gemm g{XC, WIN + (size_t)l * INP * DM, (long)NT * DM, 0, DM, DM, NB, 9, 11};
                pg8::EpiP E{PB, STAT}; REP(3) pg8::gemm_phase(lds, g, G, bx, E);
            } else if (sub == 2 && EN(3)) {
                REP(6) {
                if (EN(10)) { pg8::Gemm g{WS + 2048, PB + O_FN, 0, (long)NT * INP, INP, 256, NB, 2, l == 0 ? 9 : 8};
                  pg8::EpiBf<true> E{ZC, 512L * TL, TL, 0, ZCC, 512L * TC, TC, 8}; pg8::gemm_phase(lds, g, G, bx, E); }
                if (EN(11)) { pg8::Gemm g{PB, WS + l * 1024, (long)NT * INP, 0, INP, 256, NB, l == 0 ? 9 : 8, 3};
                  pg8::EpiQK<true> E{QB, 192, STAT, COST, SINT}; pg8::gemm_phase(lds, g, G, bx, E); }
                if (EN(12)) { pg8::Gemm g{PB + O_CKV, WS + l * 1024 + 256, (long)NT * INP, 0, INP, 256, NB, 9, 3};
                  pg8::EpiQK<false> E{KB, KP, STAT, COST, SINT}; pg8::gemm_phase(lds, g, G, bx, E); }
                if (EN(13)) { pg8::Gemm g{WS + l * 1024 + 512, PB + O_CKV, 0, (long)NT * INP, INP, 256, NB, 2, 9};
                  pg8::EpiVt E{VT, STAT}; pg8::gemm_phase(lds, g, G, bx, E); }
                }
                if (EN(14)) REP(0) for (int j = bx; j < NB * 8; j += G) scan_job(lds, j >> 3, (j >> 1) & 3, j & 1, l, PB, lbp, XC, OB);
            } else if (sub == 3 && EN(4)) {
                if (EN(15)) { pg8::Gemm g{DMAT, ZC, 0, 512L * TL, 4096, 4096, NB, 8, 1};
                  pg8::EpiBf<true> E{XC, (long)NT * DM, DM, 768, XC, 0, DM, 1 << 30}; REP(5) pg8::gemm_phase(lds, g, G, bx, E); }
                if (l == 0 && EN(16)) { pg8::Gemm g{DCM, ZCC, 0, 512L * TC, 512, 512, NB, 1, 1};
                  pg8::EpiBf<true> E{XC + (size_t)TL * DM, (long)NT * DM, DM, 768, XC, 0, DM, 1 << 30}; pg8::gemm_phase(lds, g, G, bx, E); }
                __syncthreads();
                if (EN(17)) { const int nun = NB * 4 * 8 + (l == 0 ? NB * 4 : 0);
                  REP(1) for (int un = vcu; un < nun; un += G) {
                      if (un < NB * 32) { const int bh = un >> 3, qb = un & 7; attn_unit(lds, bh >> 2, bh & 3, qb * 256, 0, NT / 64, QB, KB, VT, XC); }
                      else { const int bh = un - NB * 32; attn_unit(lds, bh >> 2, bh & 3, TL, TL, TC / 64, QB, KB, VT, XC); } } }
                if (EN(18)) for (int R0 = 2 * gw; R0 < MR; R0 += 2 * NGW) { const int b = R0 / NT, n = R0 - b * NT; if (n >= TL && l == 1) continue;
                    const int col = lane * 4; const f32x4 g4 = *(const f32x4*)(hgg + l * 256 + col);
                    u32x2 fw[2], bw[2], zw[2];
#pragma unroll
                    for (int q = 0; q < 2; ++q) { const size_t R = (size_t)R0 + q; fw[q] = *(const u32x2*)(XC + R * DM + 512 + col); bw[q] = *(const u32x2*)(OB + R * 256 + col); zw[q] = *(const u32x2*)(PB + R * INP + O_HG + col); }
#pragma unroll
                    for (int q = 0; q < 2; ++q) { const size_t R = (size_t)R0 + q;
                        float o[4] = {bflo(fw[q].x) + bflo(bw[q].x), bfhi(fw[q].x) + bfhi(bw[q].x), bflo(fw[q].y) + bflo(bw[q].y), bfhi(fw[q].y) + bfhi(bw[q].y)};
                        float ss = (o[0] * o[0] + o[1] * o[1]) + (o[2] * o[2] + o[3] * o[3]);
                        ss += __shfl_xor(ss, 1); ss += __shfl_xor(ss, 2); ss += __shfl_xor(ss, 4); ss += __shfl_xor(ss, 8);
                        const float r = rsqrtf(ss * (1.f / 64.f) + EPS);
                        const float z[4] = {bflo(zw[q].x), bfhi(zw[q].x), bflo(zw[q].y), bfhi(zw[q].y)}; float y[4];
#pragma unroll
                        for (int i = 0; i < 4; ++i) y[i] = o[i] * r * g4[i] * silu_f(z[i]);
                        u32x2 w; w.x = cvt_pk(y[0], y[1]); w.y = cvt_pk(y[2], y[3]); *(u32x2*)(XC + R * DM + 512 + col) = w; } }
            } else if (sub == 4 && EN(5)) {
                pg8::Gemm g{XC, WOUT + (size_t)l * DM * DM, (long)NT * DM, 0, DM, DM, NB, l == 0 ? 9 : 8, 4};
                pg8::EpiRes<l == 0> E{x_in, ctx_in, XR, XR, modl + 2048}; pg8::gemm_phase(lds, g, G, bx, E);
            } else if (sub == 6 && EN(6)) {
                pg8::Gemm g{XC, WGU + (size_t)l * 5632 * DM, (long)NT * DM, 0, DM, DM, NB, l == 0 ? 9 : 8, 22};
                pg8::EpiGU E{PB}; REP(2) pg8::gemm_phase(lds, g, G, bx, E);
            } else if (sub == 7 && EN(7)) {
                pg8::Gemm g{PB, WDN + (size_t)l * DM * FF, (long)NT * FF, 0, FF, FF, NB, l == 0 ? 9 : 8, 4};
                pg8::EpiRes<false> E{x_in, ctx_in, XR, l == 0 ? XR : XC, modl + 5120}; pg8::gemm_phase(lds, g, G, bx, E);
            }
        }
}

__global__ void __launch_bounds__(512, 2) mk_fwd(Args args) {
    extern __shared__ __attribute__((aligned(16))) unsigned char lds_raw[];
    LAS unsigned char* lds = (LAS unsigned char*)lds_raw;
    XcdBarrier bar; bar.bar = (unsigned*)(args.ws + W_CTL); bar.x = 0; bar.st = nullptr;
    if (args.ph_hi - args.ph_lo > 1) {
        if (threadIdx.x < 2) ((volatile LAS unsigned*)(lds + LDS_BARST))[threadIdx.x] = 0u;
        __syncthreads();
        bar = xcd_barrier_post((unsigned*)(args.ws + W_CTL), (volatile LAS unsigned*)(lds + LDS_BARST));
    }
#define PHASE(k) if (args.ph_lo <= (k) && (k) < args.ph_hi) { phase_body<k>(args, lds); if ((k) + 1 < args.ph_hi) { if (args.ph_hi > 1000) cg::this_grid().sync(); else xcd_barrier(bar); } }
    PHASE(0) PHASE(1) PHASE(2) PHASE(3) PHASE(4) PHASE(5) PHASE(6) PHASE(7) PHASE(8) PHASE(9) PHASE(10) PHASE(11) PHASE(12) PHASE(13) PHASE(14) PHASE(15) PHASE(16) PHASE(17)
#undef PHASE
}

extern "C" void kernel_launch(void* const* d_in, const int* in_sizes, int n_in, void* d_out, int out_size, void* d_ws, size_t ws_size, hipStream_t stream) {
    static int grid = 0;
    if (grid == 0) {
        if (n_in != 20 || out_size != NB * TL * DM || ws_size < W_END) { fprintf(stderr, "kernel_launch: unexpected problem (n_in %d out %d ws %zu need %zu)\n", n_in, out_size, ws_size, (size_t)W_END); grid = -1; return; }
        int dev = 0, cus = 0, per_cu = 0;
        hipGetDevice(&dev); hipDeviceGetAttribute(&cus, hipDeviceAttributeMultiprocessorCount, dev);
        if (hipFuncSetAttribute((const void*)mk_fwd, hipFuncAttributeMaxDynamicSharedMemorySize, LDS_BYTES) != hipSuccess) { fprintf(stderr, "kernel_launch: hipFuncSetAttribute failed\n"); grid = -1; return; }
        if (hipOccupancyMaxActiveBlocksPerMultiprocessor(&per_cu, (const void*)mk_fwd, 512, LDS_BYTES) != hipSuccess || per_cu < 1) { fprintf(stderr, "kernel_launch: occupancy query gave %d\n", per_cu); per_cu = 1; }
        (void)hipGetLastError();
        grid = cus * (per_cu > 1 ? 1 : per_cu);
        if (grid <= 0) grid = 256;
    }
    if (grid < 0) return;
    Args a{};
    for (int i = 0; i < 20; ++i) a.in[i] = (const float*)d_in[i];
    a.out = (float*)d_out; a.ws = (unsigned char*)d_ws;
#if MK_MULTI
    for (int ph = 0; ph < NPHASE; ++ph) { a.ph_lo = ph; a.ph_hi = ph + 1; hipLaunchKernelGGL(mk_fwd, dim3(grid), dim3(512), LDS_BYTES, stream, a); }
#else
    a.ph_lo = 0; a.ph_hi = NPHASE;
    if (hipMemsetAsync((char*)d_ws + W_CTL, 0, CTL_BYTES, stream) != hipSuccess) { fprintf(stderr, "kernel_launch: memset failed\n"); return; }
    void* kargs[] = {&a};
    hipError_t e = hipLaunchCooperativeKernel((const void*)mk_fwd, dim3(grid), dim3(512), kargs, LDS_BYTES, stream);
    if (e != hipSuccess) fprintf(stderr, "kernel_launch: cooperative launch failed: %s (grid %d)\n", hipGetErrorString(e), grid);
#endif
}
```

```cpp
#include <hip/hip_runtime.h>
#include <hip/hip_cooperative_groups.h>
#include <cstdio>
#include <cstdint>
namespace cg = cooperative_groups;

#ifndef MK_MULTI
#define MK_MULTI 0
#endif

#ifndef ONLY_MASK
#define ONLY_MASK 0x7ffff
#endif
#define EN(k) (((ONLY_MASK) >> (k)) & 1)
#ifndef DUP
#define DUP 0
#endif
#define REP(bit) for (int rep_ = 0; rep_ < (((DUP) >> (bit)) & 1) + 1; ++rep_)
#define LAS __attribute__((address_space(3)))
typedef unsigned short bf16_t;
typedef short bf16x8 __attribute__((ext_vector_type(8)));
typedef short s16x4 __attribute__((ext_vector_type(4)));
typedef float f32x4 __attribute__((ext_vector_type(4)));
typedef float f32x16 __attribute__((ext_vector_type(16)));
typedef unsigned u32x4 __attribute__((ext_vector_type(4)));
typedef unsigned u32x2 __attribute__((ext_vector_type(2)));

constexpr int NB = 32, TL = 2048, TC = 256, NT = 2304, MR = NB * NT, DM = 1024;
constexpr int INW = 2752, INP = 2816, FF = 2816;
constexpr int O_CKV = 256, O_KR = 384, O_HQ = 448, O_HFF = 960, O_HFB = 1472, O_HI = 1984, O_HG = 2240, O_FN = 2496;
constexpr float EPS = 1e-6f;
constexpr int KP = 200;
constexpr float QSCALE = 0.07216878364870322f * 1.4426950408889634f;

constexpr size_t MiB = 1u << 20;
constexpr size_t W_WIN = 0;
constexpr size_t W_WGU = W_WIN + 2ull * INP * DM * 2;
constexpr size_t W_WDN = W_WGU + 2ull * 5632 * DM * 2;
constexpr size_t W_WOUT = W_WDN + 2ull * DM * FF * 2;
constexpr size_t W_WS = W_WOUT + 2ull * DM * DM * 2;
constexpr size_t W_DM = W_WS + 768ull * INP * 2;
constexpr size_t W_DC = W_DM + 2048ull * 4096 * 2;
constexpr size_t W_COS = W_DC + 256ull * 512 * 2;
constexpr size_t W_SIN = W_COS + 2048ull * 32 * 4;
constexpr size_t W_MOD = W_SIN + 2048ull * 32 * 4;
constexpr size_t W_STAT = W_MOD + 2ull * 33 * 6144 * 4;
constexpr size_t W_OB = (W_STAT + (size_t)MR * 8 * 4 + 4095) / 4096 * 4096;
constexpr size_t W_ZC = W_OB + (size_t)MR * 256 * 2;
constexpr size_t W_ZCC = W_ZC + 32ull * 512 * 2048 * 2;
constexpr size_t W_VT = W_ZCC + 32ull * 512 * 256 * 2;
constexpr size_t W_K = W_VT + 32ull * 512 * NT * 2;
constexpr size_t W_Q = W_K + 128ull * NT * KP * 2;
constexpr size_t W_XC = W_Q + 128ull * NT * 192 * 2;
constexpr size_t W_P = W_XC + (size_t)MR * DM * 2;
constexpr size_t W_CTL = W_P + (size_t)MR * INP * 2;
constexpr size_t CTL_BYTES = 16384;
constexpr size_t W_END = W_CTL + CTL_BYTES;

constexpr int LDS_BYTES = 147456;
constexpr int NPHASE = 18;

__device__ __forceinline__ unsigned cvt_pk(float lo, float hi) { unsigned r; asm volatile("v_cvt_pk_bf16_f32 %0, %1, %2" : "=v"(r) : "v"(lo), "v"(hi)); return r; }
__device__ __forceinline__ unsigned f2bf(float f) { unsigned u = __builtin_bit_cast(unsigned, f); return (u + 0x7fffu + ((u >> 16) & 1u)) >> 16; }
__device__ __forceinline__ float bf2f(unsigned short h) { return __builtin_bit_cast(float, (unsigned)h << 16); }
__device__ __forceinline__ float bflo(unsigned w) { return __builtin_bit_cast(float, w << 16); }
__device__ __forceinline__ float bfhi(unsigned w) { return __builtin_bit_cast(float, w & 0xffff0000u); }
__device__ __forceinline__ float wave_sum(float v) {
#pragma unroll
    for (int o = 1; o < 64; o <<= 1) v += __shfl_xor(v, o);
    return v;
}
__device__ __forceinline__ float silu_f(float x) { return x / (1.f + __expf(-x)); }
__device__ __forceinline__ float sigm_f(float x) { return 1.f / (1.f + __expf(-x)); }

namespace pg8 {
constexpr int BM = 256, BK = 64, HALF = 128, HTB = HALF * BK * 2, NXCD = 8, WGM = 8;
__device__ __forceinline__ int lds_byte(int r, int c) { const int st = (r >> 4) * 2 + (c >> 5), rr = r & 15, cc = c & 31, ob = rr * 64 + cc * 2; return st * 1024 + (ob ^ (((ob >> 9) & 1) << 5)); }
__device__ __forceinline__ void stage_rc(int b, int& R, int& C) { const int st = b / 1024, sb = b % 1024, swz = sb ^ (((sb >> 9) & 1) << 5); R = (st >> 1) * 16 + swz / 64; C = (st & 1) * 32 + (swz % 64) / 2; }

__device__ __forceinline__ int perm32(int rho) { const int n = rho >> 4, i = rho & 15; return 8 * (i >> 2) + 4 * n + (i & 3); }
struct Unit { int pb, pm, pn; };
struct Gemm { const bf16_t* A; const bf16_t* Bt; long sA, sB; int ld, K, nb, nM, nN; };
struct Order {
    int nM, nN, per, nwg, G, c;
    __device__ __forceinline__ void init(const Gemm& g, int G_, int c_) { nM = g.nM; nN = g.nN; per = nM * nN; nwg = per * g.nb; G = G_; c = c_; }
    __device__ __forceinline__ bool next(int i, Unit& u) const {
        const long L = (long)i * G + c; if (L >= nwg) return false;
        int w = (int)L; { const int q = nwg / NXCD, r = nwg % NXCD, xcd = w % NXCD, off = w / NXCD; w = (xcd < r ? xcd * (q + 1) : r * (q + 1) + (xcd - r) * q) + off; }
        u.pb = w / per; w -= u.pb * per;
        const int nig = WGM * nN, gid = w / nig, fm = gid * WGM, gsz = (nM - fm) < WGM ? (nM - fm) : WGM;
        u.pm = fm + ((w % nig) % gsz); u.pn = (w % nig) / gsz; return true;
    }
};
template <class Epi>
__device__ __forceinline__ void gemm_phase(LAS unsigned char* lds, const Gemm g, int G, int c, const Epi& E) {
    int tid = threadIdx.x; asm volatile("" : "+v"(tid));
    const int wid = __builtin_amdgcn_readfirstlane(tid >> 6), lane = tid & 63, wr = wid >> 2, wc = wid & 3, fr = lane & 15, fq = lane >> 4;
    const int nt = g.K / BK;
    Order S; S.init(g, G, c);
    unsigned voffA[2], voffB[2];
#pragma unroll
    for (int i = 0; i < 2; ++i) { int R, C; stage_rc(tid * 16 + i * 8192, R, C); const int Rb = Epi::PERM ? ((R & ~31) + perm32(R & 31)) : R;
        voffA[i] = (unsigned)(R * g.ld + C) * 2u; voffB[i] = Epi::PERM ? (unsigned)(Rb * g.ld + C) * 2u : voffA[i]; }
    const size_t kstep = (size_t)(BK * 2);
    const size_t hstepA = (size_t)HALF * g.ld * 2, hstepB = hstepA;
    const unsigned ldsw = (unsigned)wid * 1024u;
    const int aoff = lds_byte(wr * 64 + fr, fq * 8), boff = lds_byte(wc * 32 + fr, fq * 8);
#define PG8_SA(b, h) (((b) * 2 + (h)) * HTB)
#define PG8_SB(b, h) ((4 + (b) * 2 + (h)) * HTB)
#define PG8_STAGE(bufoff, gbase, voff) do { _Pragma("unroll") for (int _i = 0; _i < 2; ++_i) \
        __builtin_amdgcn_global_load_lds((const unsigned*)((const char*)(gbase) + (voff)[_i]), (LAS unsigned*)(lds + (bufoff) + ldsw + _i * 8192), 16, 0, 0); } while (0)
#define PG8_LDA(dst, b, h) do { _Pragma("unroll") for (int m = 0; m < 4; ++m) _Pragma("unroll") for (int k = 0; k < 2; ++k) dst[m][k] = *(const LAS bf16x8*)(lds + PG8_SA(b, h) + aoff + m * 2048 + k * 1024); } while (0)
#define PG8_LDB(dst, b, h) do { _Pragma("unroll") for (int n = 0; n < 2; ++n) _Pragma("unroll") for (int k = 0; k < 2; ++k) dst[n][k] = *(const LAS bf16x8*)(lds + PG8_SB(b, h) + boff + n * 2048 + k * 1024); } while (0)
#define PG8_MMA(ai, bj, At, Bt) do { __builtin_amdgcn_s_setprio(1); _Pragma("unroll") for (int m = 0; m < 4; ++m) _Pragma("unroll") for (int n = 0; n < 2; ++n) _Pragma("unroll") for (int k = 0; k < 2; ++k) \
        acc[ai][bj][m][n] = __builtin_amdgcn_mfma_f32_16x16x32_bf16(Bt[n][k], At[m][k], acc[ai][bj][m][n], 0, 0, 0); __builtin_amdgcn_s_setprio(0); } while (0)
#define PG8_WAIT_V(n) asm volatile("s_waitcnt vmcnt(" #n ")" ::: "memory")
#define PG8_WAIT_L(n) asm volatile("s_waitcnt lgkmcnt(" #n ")" ::: "memory")
#define PG8_BAR __builtin_amdgcn_s_barrier()
#define PG8_SCHED __builtin_amdgcn_sched_barrier(0)
    Unit cur, nxt; int ui = 0;
    if (!S.next(0, cur)) return;
    f32x4 acc[2][2][4][2];
#pragma unroll
    for (int a = 0; a < 2; ++a)
#pragma unroll
        for (int b = 0; b < 2; ++b)
#pragma unroll
            for (int m = 0; m < 4; ++m)
#pragma unroll
                for (int n = 0; n < 2; ++n) acc[a][b][m][n] = (f32x4){0.f, 0.f, 0.f, 0.f};
    bf16x8 At[4][2], B0[2][2], B1[2][2];
    const char* cA = (const char*)(g.A + (size_t)cur.pb * g.sA) + (size_t)cur.pm * 2 * hstepA;
    const char* cB = (const char*)(g.Bt + (size_t)cur.pb * g.sB) + (size_t)cur.pn * 2 * hstepB;
    PG8_STAGE(PG8_SB(0, 0), cB, voffB); PG8_STAGE(PG8_SB(0, 1), cB + hstepB, voffB); PG8_STAGE(PG8_SA(0, 0), cA, voffA); PG8_STAGE(PG8_SA(0, 1), cA + hstepA, voffA);
    if (wr == 1) PG8_BAR;
    PG8_WAIT_V(2); PG8_BAR;
    PG8_STAGE(PG8_SB(1, 0), cB + kstep, voffB); PG8_STAGE(PG8_SA(1, 0), cA + kstep, voffA); PG8_STAGE(PG8_SB(1, 1), cB + hstepB + kstep, voffB);
    PG8_WAIT_V(6); PG8_BAR;
    for (;;) {
        const bool has_next = S.next(ui + 1, nxt);
        const char* nA = has_next ? (const char*)(g.A + (size_t)nxt.pb * g.sA) + (size_t)nxt.pm * 2 * hstepA : cA;
        const char* nB = has_next ? (const char*)(g.Bt + (size_t)nxt.pb * g.sB) + (size_t)nxt.pn * 2 * hstepB : cB;
#pragma nounroll
        for (int t = 0; t < nt; t += 2) {
            const bool last = (t == nt - 2);
            const char* a1 = cA + (size_t)(t + 1) * kstep;
            const char* a2 = last ? nA : cA + (size_t)(t + 2) * kstep; const char* b2 = last ? nB : cB + (size_t)(t + 2) * kstep;
            const char* a3 = a2 + kstep; const char* b3 = b2 + kstep;
            PG8_LDB(B0, 0, 0); PG8_LDB(B1, 0, 1); PG8_SCHED; PG8_LDA(At, 0, 0); PG8_STAGE(PG8_SA(1, 1), a1 + hstepA, voffA);
            PG8_WAIT_V(8); PG8_WAIT_L(0); PG8_BAR; PG8_MMA(0, 0, At, B0); PG8_MMA(0, 1, At, B1); PG8_BAR; PG8_SCHED;
            PG8_LDA(At, 0, 1); PG8_STAGE(PG8_SB(0, 0), b2, voffB); PG8_STAGE(PG8_SB(0, 1), b2 + hstepB, voffB); PG8_STAGE(PG8_SA(0, 0), a2, voffA);
            PG8_WAIT_V(8); PG8_WAIT_L(0); PG8_BAR; PG8_MMA(1, 0, At, B0); PG8_MMA(1, 1, At, B1); PG8_BAR; PG8_SCHED;
            PG8_LDB(B0, 1, 0); PG8_LDB(B1, 1, 1); PG8_SCHED; PG8_LDA(At, 1, 0); PG8_STAGE(PG8_SA(0, 1), a2 + hstepA, voffA);
            PG8_WAIT_V(8); PG8_WAIT_L(0); PG8_BAR; PG8_MMA(0, 0, At, B0); PG8_MMA(0, 1, At, B1); PG8_BAR; PG8_SCHED;
            PG8_LDA(At, 1, 1); PG8_STAGE(PG8_SB(1, 0), b3, voffB); PG8_STAGE(PG8_SB(1, 1), b3 + hstepB, voffB); PG8_STAGE(PG8_SA(1, 0), a3, voffA);
            PG8_WAIT_V(8); PG8_WAIT_L(0); PG8_BAR; PG8_MMA(1, 0, At, B0); PG8_MMA(1, 1, At, B1); PG8_BAR; PG8_SCHED;
        }
        if (wr == 0) PG8_BAR;
        { int l2 = lane; asm volatile("" : "+v"(l2)); E(acc, cur, wr, wc, l2 & 15, l2 >> 4); }
        if (!has_next) break;
#pragma unroll
        for (int a = 0; a < 2; ++a)
#pragma unroll
            for (int b = 0; b < 2; ++b)
#pragma unroll
                for (int m = 0; m < 4; ++m)
#pragma unroll
                    for (int n = 0; n < 2; ++n) acc[a][b][m][n] = (f32x4){0.f, 0.f, 0.f, 0.f};
        cur = nxt; cA = nA; cB = nB; ++ui;
        if (wr == 1) PG8_BAR;
    }
    PG8_WAIT_V(0);
    PG8_BAR;
#undef PG8_SA
#undef PG8_SB
#undef PG8_STAGE
#undef PG8_LDA
#undef PG8_LDB
#undef PG8_MMA
#undef PG8_WAIT_V
#undef PG8_WAIT_L
#undef PG8_BAR
#undef PG8_SCHED
}

typedef f32x4 Acc[2][2][4][2];
struct EpiP {
    static constexpr bool PERM = true;
    bf16_t* P; float* stats;
    __device__ __forceinline__ void operator()(const Acc& acc, const Unit& u, int wr, int wc, int fr, int fq) const {
        const size_t Rb = (size_t)u.pb * NT + u.pm * 256 + wr * 64 + fr; const int col0 = u.pn * 256 + wc * 32 + 8 * fq;
#pragma unroll
        for (int ai = 0; ai < 2; ++ai)
#pragma unroll
            for (int m = 0; m < 4; ++m) { const size_t R = Rb + ai * 128 + m * 16; bf16_t* rowp = P + R * INP + col0;
#pragma unroll
                for (int bj = 0; bj < 2; ++bj) { const f32x4 v0 = acc[ai][bj][m][0], v1 = acc[ai][bj][m][1]; u32x4 w; w.x = cvt_pk(v0[0], v0[1]); w.y = cvt_pk(v0[2], v0[3]); w.z = cvt_pk(v1[0], v1[1]); w.w = cvt_pk(v1[2], v1[3]);
                    *(u32x4*)(rowp + bj * 128) = w; }
                if (u.pn < 2) { float s = 0.f;
#pragma unroll
                    for (int n = 0; n < 2; ++n) { const f32x4 v = acc[ai][0][m][n]; s += (v[0] * v[0] + v[1] * v[1]) + (v[2] * v[2] + v[3] * v[3]); }
                    if (u.pn == 0) {
#pragma unroll
                        for (int n = 0; n < 2; ++n) { const f32x4 v = acc[ai][1][m][n]; s += (v[0] * v[0] + v[1] * v[1]) + (v[2] * v[2] + v[3] * v[3]); } }
                    s += __shfl_xor(s, 16); s += __shfl_xor(s, 32);
                    if (fq == 0) stats[R * 8 + u.pn * 4 + wc] = s; } }
    }
};
template <bool ISQ> struct EpiQK {
    static constexpr bool PERM = true;
    bf16_t* O; int pitch; const float* stats; const float* cosT; const float* sinT;
    __device__ __forceinline__ void operator()(const Acc& acc, const Unit& u, int wr, int wc, int fr, int fq) const {
#pragma unroll
        for (int ai = 0; ai < 2; ++ai)
#pragma unroll
            for (int m = 0; m < 4; ++m) { const int row = u.pm * 256 + ai * 128 + wr * 64 + m * 16 + fr; const size_t R = (size_t)u.pb * NT + row;
                const f32x4 sa = *(const f32x4*)(stats + R * 8 + (ISQ ? 0 : 4));
                float rr = rsqrtf(((sa[0] + sa[1]) + (sa[2] + sa[3])) * (ISQ ? (1.f / 256.f) : (1.f / 128.f)) + EPS); if (ISQ) rr *= QSCALE;
#pragma unroll
                for (int bj = 0; bj < 2; ++bj) { const int cg_ = u.pn * 256 + bj * 128 + wc * 32; const int h = cg_ / 192, d0 = cg_ - h * 192;
                    f32x4 a = acc[ai][bj][m][0], b = acc[ai][bj][m][1];
                    if (d0 < 128) { a = a * rr; b = b * rr; }
                    else { if (ISQ) { a = a * rr; b = b * rr; }
                        f32x4 pa, pb;
#pragma unroll
                        for (int i = 0; i < 4; ++i) { pa[i] = __shfl_xor(a[i], 32); pb[i] = __shfl_xor(b[i], 32); }
                        if (row < TL) { const int ti = row * 32 + ((d0 - 128) >> 5) * 16 + 8 * (fq & 1); const float sg = fq < 2 ? -1.f : 1.f;
                            const f32x4 c0 = *(const f32x4*)(cosT + ti), c1 = *(const f32x4*)(cosT + ti + 4), s0 = *(const f32x4*)(sinT + ti) * sg, s1 = *(const f32x4*)(sinT + ti + 4) * sg;
                            a = a * c0 + pa * s0; b = b * c1 + pb * s1; } }
                    bf16_t* dst = O + ((size_t)(u.pb * 4 + h) * NT + row) * pitch + d0 + 8 * fq;
                    u32x4 w; w.x = cvt_pk(a[0], a[1]); w.y = cvt_pk(a[2], a[3]); w.z = cvt_pk(b[0], b[1]); w.w = cvt_pk(b[2], b[3]); *(u32x4*)dst = w; } }
    }
};
struct EpiVt {
    static constexpr bool PERM = true;
    bf16_t* Vt; const float* stats;
    __device__ __forceinline__ void operator()(const Acc& acc, const Unit& u, int wr, int wc, int fr, int fq) const {
        f32x4 rk[2][2];
#pragma unroll
        for (int bj = 0; bj < 2; ++bj)
#pragma unroll
            for (int n = 0; n < 2; ++n) { const int col = u.pn * 256 + bj * 128 + wc * 32 + 8 * fq + 4 * n;
#pragma unroll
                for (int i = 0; i < 4; ++i) { const f32x4 sa = *(const f32x4*)(stats + ((size_t)u.pb * NT + col + i) * 8 + 4); rk[bj][n][i] = rsqrtf(((sa[0] + sa[1]) + (sa[2] + sa[3])) * (1.f / 128.f) + EPS); } }
#pragma unroll
        for (int ai = 0; ai < 2; ++ai)
#pragma unroll
            for (int m = 0; m < 4; ++m) { const int row = u.pm * 256 + ai * 128 + wr * 64 + m * 16 + fr; bf16_t* rowp = Vt + ((size_t)u.pb * 512 + row) * NT + u.pn * 256 + wc * 32 + 8 * fq;
#pragma unroll
                for (int bj = 0; bj < 2; ++bj) { const f32x4 v0 = acc[ai][bj][m][0] * rk[bj][0], v1 = acc[ai][bj][m][1] * rk[bj][1]; u32x4 w; w.x = cvt_pk(v0[0], v0[1]); w.y = cvt_pk(v0[2], v0[3]); w.z = cvt_pk(v1[0], v1[1]); w.w = cvt_pk(v1[2], v1[3]);
                    *(u32x4*)(rowp + bj * 128) = w; } }
    }
};
template <bool PM> struct EpiBf {
    static constexpr bool PERM = PM;
    bf16_t* O; long sO; int ldc, coff; bf16_t* O2; long sO2; int ldc2, split;
    __device__ __forceinline__ void operator()(const Acc& acc, const Unit& u, int wr, int wc, int fr, int fq) const {
        const bool second = u.pn >= split; bf16_t* base = second ? O2 + (size_t)u.pb * sO2 : O + (size_t)u.pb * sO + coff; const int ld = second ? ldc2 : ldc;
        const int col0 = (second ? u.pn - split : u.pn) * 256 + wc * 32 + (PM ? 8 : 4) * fq;
#pragma unroll
        for (int ai = 0; ai < 2; ++ai)
#pragma unroll
            for (int m = 0; m < 4; ++m) { const int row = u.pm * 256 + ai * 128 + wr * 64 + m * 16 + fr; bf16_t* rowp = base + (size_t)row * ld + col0;
#pragma unroll
                for (int bj = 0; bj < 2; ++bj) { const f32x4 v0 = acc[ai][bj][m][0], v1 = acc[ai][bj][m][1]; u32x4 w; w.x = cvt_pk(v0[0], v0[1]); w.y = cvt_pk(v0[2], v0[3]); w.z = cvt_pk(v1[0], v1[1]); w.w = cvt_pk(v1[2], v1[3]);
                    if (PM) *(u32x4*)(rowp + bj * 128) = w; else { *(u32x2*)(rowp + bj * 128) = (u32x2){w.x, w.y}; *(u32x2*)(rowp + bj * 128 + 16) = (u32x2){w.z, w.w}; } } }
    }
};
template <bool INF32> struct EpiRes {
    static constexpr bool PERM = true;
    const float* inL; const float* inC; const bf16_t* inB; bf16_t* outB; const float* gate;
    __device__ __forceinline__ void operator()(const Acc& acc, const Unit& u, int wr, int wc, int fr, int fq) const {
        const bool isc = u.pm == 8;
        const size_t rb = isc ? (size_t)u.pb * TC : (size_t)u.pb * TL + u.pm * 256;
        const float* in = (isc ? inC : inL) + rb * DM; const float* gp = gate + (isc ? 32 : u.pb) * 6144;
        const int col0 = u.pn * 256 + wc * 32 + 8 * fq; const size_t Rg = (size_t)u.pb * NT + u.pm * 256;
        f32x4 gv[2][2];
#pragma unroll
        for (int bj = 0; bj < 2; ++bj)
#pragma unroll
            for (int n = 0; n < 2; ++n) gv[bj][n] = *(const f32x4*)(gp + col0 + bj * 128 + n * 4);
#pragma unroll
        for (int ai = 0; ai < 2; ++ai)
#pragma unroll
            for (int m = 0; m < 4; ++m) { const int rl = ai * 128 + wr * 64 + m * 16 + fr; const size_t off = (size_t)rl * DM + col0; const size_t boff = (Rg + rl) * DM + col0;
#pragma unroll
                for (int bj = 0; bj < 2; ++bj) { f32x4 x0, x1;
                    if (INF32) { x0 = *(const f32x4*)(in + off + bj * 128); x1 = *(const f32x4*)(in + off + bj * 128 + 4); }
                    else { const u32x4 q = *(const u32x4*)(inB + boff + bj * 128); x0 = (f32x4){bflo(q.x), bfhi(q.x), bflo(q.y), bfhi(q.y)}; x1 = (f32x4){bflo(q.z), bfhi(q.z), bflo(q.w), bfhi(q.w)}; }
                    x0 = x0 + gv[bj][0] * acc[ai][bj][m][0]; x1 = x1 + gv[bj][1] * acc[ai][bj][m][1];
                    u32x4 w; w.x = cvt_pk(x0[0], x0[1]); w.y = cvt_pk(x0[2], x0[3]); w.z = cvt_pk(x1[0], x1[1]); w.w = cvt_pk(x1[2], x1[3]); *(u32x4*)(outB + boff + bj * 128) = w; } }
    }
};
struct EpiGU {
    static constexpr bool PERM = true;
    bf16_t* H;
    __device__ __forceinline__ void operator()(const Acc& acc, const Unit& u, int wr, int wc, int fr, int fq) const {
        const size_t Rb = (size_t)u.pb * NT + u.pm * 256 + wr * 64 + fr; const int col0 = u.pn * 128 + wc * 32 + 8 * fq;
#pragma unroll
        for (int ai = 0; ai < 2; ++ai)
#pragma unroll
            for (int m = 0; m < 4; ++m) { bf16_t* rowp = H + (Rb + ai * 128 + m * 16) * FF + col0; f32x4 v[2];
#pragma unroll
                for (int n = 0; n < 2; ++n) { const f32x4 gt = acc[ai][0][m][n], up = acc[ai][1][m][n];
#pragma unroll
                    for (int i = 0; i < 4; ++i) v[n][i] = gt[i] * __builtin_amdgcn_rcpf(1.f + __builtin_amdgcn_exp2f(-1.4426950408889634f * gt[i])) * up[i]; }
                u32x4 w; w.x = cvt_pk(v[0][0], v[0][1]); w.y = cvt_pk(v[0][2], v[0][3]); w.z = cvt_pk(v[1][0], v[1][1]); w.w = cvt_pk(v[1][2], v[1][3]); *(u32x4*)rowp = w; }
    }
};
}

constexpr int AK_BYTES = 64 * KP * 2  , AV_PITCH = 136, AV_BYTES = 128 * AV_PITCH  ;
__device__ __forceinline__ void attn_unit(LAS unsigned char* lds, int b, int h, int q0, int kbeg, int ntiles, const bf16_t* Q, const bf16_t* K, const bf16_t* Vt, bf16_t* cat) {
    int tid = threadIdx.x; asm volatile("" : "+v"(tid));
    const int lane = tid & 63, r32 = lane & 31, hi = lane >> 5; const int wid = __builtin_amdgcn_readfirstlane(tid >> 6);
    const char* Kg = (const char*)(K + ((size_t)(b * 4 + h) * NT + kbeg) * KP);
    const bf16_t* Vg = Vt + (size_t)(b * 4 + h) * 128 * NT + kbeg;
    bf16x8 qf[12];
    { const bf16_t* Qg = Q + ((size_t)(b * 4 + h) * NT + q0 + wid * 32 + r32) * 192 + hi * 8;
#pragma unroll
      for (int ds = 0; ds < 12; ++ds) qf[ds] = *(const bf16x8*)(Qg + ds * 16); }
    f32x16 o[4];
#pragma unroll
    for (int d = 0; d < 4; ++d)
#pragma unroll
        for (int r = 0; r < 16; ++r) o[d][r] = 0.f;
    float mrun = -1e30f, lrun = 0.f;
    u32x4 vr[2];
    const int vd0 = tid >> 3, vpart = tid & 7;
#define ALOAD(kt) do { const char* ks_ = Kg + (size_t)(kt) * AK_BYTES + tid * 16; \
        kr[0] = *(const u32x4*)(ks_); kr[1] = *(const u32x4*)(ks_ + 8192); kr[2] = *(const u32x4*)(ks_ + 16384); if (tid < 64) kr[3] = *(const u32x4*)(ks_ + 24576); \
        vr[0] = *(const u32x4*)(Vg + (size_t)vd0 * NT + (kt) * 64 + vpart * 8); vr[1] = *(const u32x4*)(Vg + (size_t)(vd0 + 64) * NT + (kt) * 64 + vpart * 8); } while (0)
#define ASTORE(buf) do { LAS unsigned char* kd_ = lds + (buf) * AK_BYTES + tid * 16; \
        *(LAS u32x4*)(kd_) = kr[0]; *(LAS u32x4*)(kd_ + 8192) = kr[1]; *(LAS u32x4*)(kd_ + 16384) = kr[2]; if (tid < 64) *(LAS u32x4*)(kd_ + 24576) = kr[3]; \
        LAS unsigned char* vd_ = lds + 2 * AK_BYTES + (buf) * AV_BYTES + vd0 * AV_PITCH + vpart * 16; \
        *(LAS u32x2*)(vd_) = (u32x2){vr[0].x, vr[0].y}; *(LAS u32x2*)(vd_ + 8) = (u32x2){vr[0].z, vr[0].w}; \
        *(LAS u32x2*)(vd_ + 64 * AV_PITCH) = (u32x2){vr[1].x, vr[1].y}; *(LAS u32x2*)(vd_ + 64 * AV_PITCH + 8) = (u32x2){vr[1].z, vr[1].w}; } while (0)
#define ALOADK(kt, buf) do { const char* ks_ = Kg + (size_t)(kt) * AK_BYTES + lane * 16; LAS unsigned char* kd_ = lds + (buf) * AK_BYTES; \
        _Pragma("unroll") for (int pj = 0; pj < 3; ++pj) __builtin_amdgcn_global_load_lds((const unsigned*)(ks_ + (wid + 8 * pj) * 1024), (LAS unsigned*)(kd_ + (wid + 8 * pj) * 1024), 16, 0, 0); \
        if (wid == 0) __builtin_amdgcn_global_load_lds((const unsigned*)(ks_ + 24 * 1024), (LAS unsigned*)(kd_ + 24 * 1024), 16, 0, 0); } while (0)
#define ALOADV(kt) do { vr[0] = *(const u32x4*)(Vg + (size_t)vd0 * NT + (kt) * 64 + vpart * 8); vr[1] = *(const u32x4*)(Vg + (size_t)(vd0 + 64) * NT + (kt) * 64 + vpart * 8); } while (0)
#define ASTOREV(buf) do { LAS unsigned char* vd_ = lds + 2 * AK_BYTES + (buf) * AV_BYTES + vd0 * AV_PITCH + vpart * 16; \
        *(LAS u32x2*)(vd_) = (u32x2){vr[0].x, vr[0].y}; *(LAS u32x2*)(vd_ + 8) = (u32x2){vr[0].z, vr[0].w}; \
        *(LAS u32x2*)(vd_ + 64 * AV_PITCH) = (u32x2){vr[1].x, vr[1].y}; *(LAS u32x2*)(vd_ + 64 * AV_PITCH + 8) = (u32x2){vr[1].z, vr[1].w}; } while (0)
    ALOADK(0, 0); ALOADV(0); ASTOREV(0);
    if (ntiles > 1) ALOADK(1, 1);
    asm volatile("s_waitcnt vmcnt(0)" ::: "memory");
    __syncthreads();
    f32x16 pc0, pc1;
    { const LAS unsigned char* kb = lds + r32 * (KP * 2) + hi * 16;
#pragma unroll
      for (int r = 0; r < 16; ++r) { pc0[r] = 0.f; pc1[r] = 0.f; }
#pragma unroll
      for (int ds = 0; ds < 12; ++ds) {
          const bf16x8 k0 = *(const LAS bf16x8*)(kb + ds * 32), k1 = *(const LAS bf16x8*)(kb + 32 * (KP * 2) + ds * 32);
          pc0 = __builtin_amdgcn_mfma_f32_32x32x16_bf16(k0, qf[ds], pc0, 0, 0, 0);
          pc1 = __builtin_amdgcn_mfma_f32_32x32x16_bf16(k1, qf[ds], pc1, 0, 0, 0); } }
    float mxc;
    { float mx = fmaxf(pc0[0], pc1[0]);
#pragma unroll
      for (int r = 1; r < 16; ++r) mx = fmaxf(mx, fmaxf(pc0[r], pc1[r]));
      mxc = fmaxf(mx, __shfl_xor(mx, 32)); }
    __syncthreads();
    for (int kt = 0; kt < ntiles; ++kt) {
        const int buf = kt & 1;
        if (kt + 2 < ntiles) ALOADK(kt + 2, buf);
        if (kt + 1 < ntiles) ALOADV(kt + 1);
        if (__any(mxc > mrun + 8.f)) {
            const float mnew = fmaxf(mrun, mxc), alpha = __builtin_amdgcn_exp2f(mrun - mnew);
            mrun = mnew; lrun *= alpha;
#pragma unroll
            for (int d = 0; d < 4; ++d)
#pragma unroll
                for (int r = 0; r < 16; ++r) o[d][r] *= alpha;
        }
        const LAS unsigned char* kb = lds + (buf ^ 1) * AK_BYTES + r32 * (KP * 2) + hi * 16;
        f32x16 pn0, pn1;
#pragma unroll
        for (int r = 0; r < 16; ++r) { pn0[r] = 0.f; pn1[r] = 0.f; }
        float ps = 0.f; u32x4 pw[4];
        bf16x8 ka = *(const LAS bf16x8*)(kb), kbb = *(const LAS bf16x8*)(kb + 32 * (KP * 2));
#pragma unroll
        for (int ds = 0; ds < 12; ++ds) {
            bf16x8 na = ka, nb = kbb;
            if (ds < 11) { na = *(const LAS bf16x8*)(kb + (ds + 1) * 32); nb = *(const LAS bf16x8*)(kb + 32 * (KP * 2) + (ds + 1) * 32); }
            pn0 = __builtin_amdgcn_mfma_f32_32x32x16_bf16(ka, qf[ds], pn0, 0, 0, 0);
            pn1 = __builtin_amdgcn_mfma_f32_32x32x16_bf16(kbb, qf[ds], pn1, 0, 0, 0);
            if (ds < 8) {
                float e[4];
#pragma unroll
                for (int j = 0; j < 4; ++j) { const float v = ds < 4 ? pc0[4 * ds + j] : pc1[4 * (ds - 4) + j]; e[j] = __builtin_amdgcn_exp2f(v - mrun); }
                ps += (e[0] + e[1]) + (e[2] + e[3]);
                const unsigned w0 = cvt_pk(e[0], e[1]), w1 = cvt_pk(e[2], e[3]);
                if ((ds & 1) == 0) { pw[ds >> 1].x = w0; pw[ds >> 1].y = w1; } else { pw[ds >> 1].z = w0; pw[ds >> 1].w = w1; }
            }
            ka = na; kbb = nb;
            __builtin_amdgcn_sched_barrier(0);
        }
        lrun += ps;
        const LAS unsigned char* vb = lds + 2 * AK_BYTES + buf * AV_BYTES + r32 * AV_PITCH + hi * 8;
#pragma unroll
        for (int d = 0; d < 4; ++d)
#pragma unroll
            for (int ks = 0; ks < 4; ++ks) {
                const s16x4 lo = *(const LAS s16x4*)(vb + d * 32 * AV_PITCH + ks * 32), hh = *(const LAS s16x4*)(vb + d * 32 * AV_PITCH + ks * 32 + 16);
                const bf16x8 vf = (bf16x8){lo[0], lo[1], lo[2], lo[3], hh[0], hh[1], hh[2], hh[3]};
                o[d] = __builtin_amdgcn_mfma_f32_32x32x16_bf16(vf, __builtin_bit_cast(bf16x8, pw[ks]), o[d], 0, 0, 0);
            }
        { float mx = fmaxf(pn0[0], pn1[0]);
#pragma unroll
          for (int r = 1; r < 16; ++r) mx = fmaxf(mx, fmaxf(pn0[r], pn1[r]));
          mxc = fmaxf(mx, __shfl_xor(mx, 32)); }
        if (kt + 1 < ntiles) ASTOREV(buf ^ 1);
        asm volatile("s_waitcnt vmcnt(0)" ::: "memory");
        __syncthreads();
        pc0 = pn0; pc1 = pn1;
    }
#undef ALOADK
#undef ALOADV
#undef ASTOREV
#undef ALOAD
#undef ASTORE
    const float inv = 1.f / (lrun + __shfl_xor(lrun, 32));
    bf16_t* op = cat + ((size_t)b * NT + q0 + wid * 32 + r32) * DM + h * 128 + 4 * hi;
#pragma unroll
    for (int d = 0; d < 4; ++d)
#pragma unroll
        for (int gq = 0; gq < 4; ++gq) { u32x2 w; w.x = cvt_pk(o[d][4 * gq] * inv, o[d][4 * gq + 1] * inv); w.y = cvt_pk(o[d][4 * gq + 2] * inv, o[d][4 * gq + 3] * inv); *(u32x2*)(op + d * 32 + gq * 8) = w; }
}

__device__ __forceinline__ int scan_row(int b, int dir, int s) { if (s < TC) return b * NT + TL + (dir ? TC - 1 - s : s); const int li = s - TC; return b * NT + (dir ? TL - 1 - li : li); }
constexpr int S_QT = 0, S_QH = 17408, S_KD = 34816, S_KX = 52224, S_K4T = 78336, S_VT = 96768, S_ST = 105984, S_P = 123392, S_TOT = 132608, S_TS = 133120, S_LB = 137216;
__device__ __forceinline__ void scan_job(LAS unsigned char* lds, int b, int h, int dir, int layer, const bf16_t* P, const float* lbp, bf16_t* xc, bf16_t* ob) {
    int tid = threadIdx.x; asm volatile("" : "+v"(tid));
    const int lane = tid & 63; const int wid = __builtin_amdgcn_readfirstlane(tid >> 6);
    const int kp = tid & 63, g = wid, si = g >> 1;
    const int l15 = lane & 15, lq = lane >> 4;
    LAS float* TOT = (LAS float*)(lds + S_TOT); LAS float* TS = (LAS float*)(lds + S_TS); LAS float* LB = (LAS float*)(lds + S_LB);
    __syncthreads();
    if (tid < 128) { float lb = 0.f; if (layer == 1) { const float a0 = lbp[(0 * 2 + dir) * 512 + h * 128 + tid], a1 = lbp[(1 * 2 + dir) * 512 + h * 128 + tid]; lb = 1.f / (1.f + __expf(a0 - a1)); } LB[tid] = lb; }
    for (int i = tid; i < (17408 + 9216) / 16; i += 512) { const int off = i < 1088 ? S_ST + i * 16 : S_P + (i - 1088) * 16; *(LAS u32x4*)(lds + off) = (u32x4){0u, 0u, 0u, 0u}; }
    const int zoff = dir ? O_HFB : O_HFF; const long rstep = dir ? -(long)INP : (long)INP;
    f32x4 Sacc[4];
#pragma unroll
    for (int j = 0; j < 4; ++j) Sacc[j] = (f32x4){0.f, 0.f, 0.f, 0.f};
    unsigned q2[8], z2[8]; u32x2 vra, vrb;
#define CLOAD(ch) do { const bf16_t* pr_ = P + (size_t)scan_row(b, dir, (ch) * 64 + g * 8) * INP + h * 128 + 2 * kp; \
        _Pragma("unroll") for (int tt = 0; tt < 8; ++tt) { q2[tt] = *(const unsigned*)(pr_ + O_HQ); z2[tt] = *(const unsigned*)(pr_ + zoff); pr_ += rstep; } \
        vra = *(const u32x2*)(P + (size_t)scan_row(b, dir, (ch) * 64 + 2 * (tid >> 4)) * INP + O_HI + h * 64 + (tid & 15) * 4); \
        vrb = *(const u32x2*)(P + (size_t)scan_row(b, dir, (ch) * 64 + 2 * (tid >> 4) + 1) * INP + O_HI + h * 64 + (tid & 15) * 4); } while (0)
    CLOAD(0);
    __syncthreads();
    const float lb0 = LB[2 * kp], lb1 = LB[2 * kp + 1];
    for (int ch = 0; ch < NT / 64; ++ch) {
        float qv[2][8], kk[2][8], pf[2][8];
#pragma unroll
        for (int c = 0; c < 2; ++c) { float run = 1.f; const float lb = c ? lb1 : lb0;
#pragma unroll
            for (int tt = 0; tt < 8; ++tt) { const float xq = c ? bfhi(q2[tt]) : bflo(q2[tt]), xz = c ? bfhi(z2[tt]) : bflo(z2[tt]);
                qv[c][tt] = xq * __builtin_amdgcn_rcpf(1.f + __builtin_amdgcn_exp2f(-1.4426950408889634f * xq));
                const float f = lb + (1.f - lb) * __builtin_amdgcn_rcpf(1.f + __builtin_amdgcn_exp2f(-1.4426950408889634f * xz));
                kk[c][tt] = 1.f - f; run = fmaxf(run * f, 7.888609052210118e-31f); pf[c][tt] = run; }
            TS[g * 128 + 2 * kp + c] = __builtin_amdgcn_logf(run); }
        { const int s2 = 2 * (tid >> 4), v4 = (tid & 15) * 4; LAS unsigned* vt = (LAS unsigned*)(lds + S_VT + v4 * 144 + s2 * 2);
          vt[0] = (vra.x & 0xffffu) | (vrb.x << 16); vt[36] = (vra.x >> 16) | (vrb.x & 0xffff0000u); vt[72] = (vra.y & 0xffffu) | (vrb.y << 16); vt[108] = (vra.y >> 16) | (vrb.y & 0xffff0000u); }
        __syncthreads();
        if (ch + 1 < NT / 64) CLOAD(ch + 1);
        { float qa[2][8], ka[2][8], eBv[2], e1v[2], e2v[2], e3v[2], eTv[2];
          typedef float f32x2_ __attribute__((ext_vector_type(2))); f32x2_ tsv[8];
#pragma unroll
          for (int j = 0; j < 8; ++j) tsv[j] = *(const LAS f32x2_*)(TS + j * 128 + 2 * kp);
#pragma unroll
          for (int c = 0; c < 2; ++c) { const int k = 2 * kp + c; float Bg[9]; Bg[0] = 0.f;
#pragma unroll
              for (int j = 0; j < 8; ++j) Bg[j + 1] = Bg[j] + (c ? tsv[j].y : tsv[j].x);
              const float Bi = si == 0 ? Bg[0] : (si == 1 ? Bg[2] : (si == 2 ? Bg[4] : Bg[6]));
              const float Bgg = (g & 1) ? (si == 0 ? Bg[1] : (si == 1 ? Bg[3] : (si == 2 ? Bg[5] : Bg[7]))) : Bi;
              const float eoc = __builtin_amdgcn_exp2f(Bgg - Bi);
              eBv[c] = __builtin_amdgcn_exp2f(Bi); e1v[c] = __builtin_amdgcn_exp2f(Bg[2] - Bi); e2v[c] = __builtin_amdgcn_exp2f(Bg[4] - Bi); e3v[c] = __builtin_amdgcn_exp2f(Bg[6] - Bi); eTv[c] = __builtin_amdgcn_exp2f(Bg[8] - Bi);
              if (g == 0) TOT[k] = __builtin_amdgcn_exp2f(Bg[8]);
#pragma unroll
              for (int tt = 0; tt < 8; ++tt) { const float pfu = fmaxf(pf[c][tt] * eoc, 7.888609052210118e-31f); qa[c][tt] = qv[c][tt] * pfu; ka[c][tt] = kk[c][tt] * __builtin_amdgcn_rcpf(pfu); } }
          LAS unsigned* qt = (LAS unsigned*)(lds + S_QT + (8 * g) * 272 + 4 * kp); LAS unsigned* qh = (LAS unsigned*)(lds + S_QH + (8 * g) * 272 + 4 * kp);
          LAS unsigned* kd = (LAS unsigned*)(lds + S_KD + (8 * g) * 272 + 4 * kp); LAS unsigned* kx = (LAS unsigned*)(lds + S_KX + (8 * g) * 272 + 4 * kp);
          unsigned k4[2][4];
#pragma unroll
          for (int tt = 0; tt < 8; ++tt) {
              qt[tt * 68] = cvt_pk(qa[0][tt], qa[1][tt]); qh[tt * 68] = cvt_pk(qa[0][tt] * eBv[0], qa[1][tt] * eBv[1]); kd[tt * 68] = cvt_pk(ka[0][tt], ka[1][tt]);
              if (si < 1) kx[tt * 68] = cvt_pk(ka[0][tt] * e1v[0], ka[1][tt] * e1v[1]);
              if (si < 2) kx[(16 + tt) * 68] = cvt_pk(ka[0][tt] * e2v[0], ka[1][tt] * e2v[1]);
              if (si < 3) kx[(48 + tt) * 68] = cvt_pk(ka[0][tt] * e3v[0], ka[1][tt] * e3v[1]); }
#pragma unroll
          for (int c = 0; c < 2; ++c) {
#pragma unroll
              for (int t2 = 0; t2 < 4; ++t2) k4[c][t2] = cvt_pk(ka[c][2 * t2] * eTv[c], ka[c][2 * t2 + 1] * eTv[c]);
              *(LAS u32x4*)(lds + S_K4T + (2 * kp + c) * 144 + g * 16) = (u32x4){k4[c][0], k4[c][1], k4[c][2], k4[c][3]}; } }
        __syncthreads();
        for (int bl = wid; bl < 10; bl += 8) { const int bi = bl >= 6 ? 3 : (bl >= 3 ? 2 : (bl >= 1 ? 1 : 0)), bj = bl - (bi * (bi + 1)) / 2;
            const LAS unsigned char* ap = lds + S_QT + (16 * bi + l15) * 272 + lq * 16;
            const int krow = bi == bj ? 16 * bi : (bi == 1 ? 0 : (bi == 2 ? 16 : 48)) + 16 * bj;
            const LAS unsigned char* bp = lds + (bi == bj ? S_KD : S_KX) + (krow + l15) * 272 + lq * 16;
            f32x4 sc = (f32x4){0.f, 0.f, 0.f, 0.f};
#pragma unroll
            for (int ks = 0; ks < 4; ++ks) sc = __builtin_amdgcn_mfma_f32_16x16x32_bf16(*(const LAS bf16x8*)(ap + ks * 64), *(const LAS bf16x8*)(bp + ks * 64), sc, 0, 0, 0);
            LAS bf16_t* pp = (LAS bf16_t*)(lds + S_P) + (16 * bi + 4 * lq) * 72 + 16 * bj + l15;
#pragma unroll
            for (int r = 0; r < 4; ++r) { float v = sc[r]; if (bi == bj && l15 > 4 * lq + r) v = 0.f; pp[r * 72] = (bf16_t)f2bf(v); } }
        __syncthreads();
        { const int ti = wid >> 1, vj0 = 2 * (wid & 1);
          const LAS unsigned char* pa = lds + S_P + (16 * ti + l15) * 144 + lq * 16; const LAS unsigned char* qa = lds + S_QH + (16 * ti + l15) * 272 + lq * 16;
          const bf16x8 a0 = *(const LAS bf16x8*)(pa), a1 = *(const LAS bf16x8*)(pa + 64);
          const bf16x8 q0 = *(const LAS bf16x8*)(qa), q1 = *(const LAS bf16x8*)(qa + 64), q2 = *(const LAS bf16x8*)(qa + 128), q3 = *(const LAS bf16x8*)(qa + 192);
          const size_t row0 = (size_t)scan_row(b, dir, ch * 64 + 16 * ti + 4 * lq);
#pragma unroll
          for (int vv = 0; vv < 2; ++vv) { const int vj = vj0 + vv;
              const LAS unsigned char* vb = lds + S_VT + (16 * vj + l15) * 144 + lq * 16; const LAS unsigned char* sb = lds + S_ST + (16 * vj + l15) * 272 + lq * 16;
              f32x4 o = (f32x4){0.f, 0.f, 0.f, 0.f};
              o = __builtin_amdgcn_mfma_f32_16x16x32_bf16(a0, *(const LAS bf16x8*)(vb), o, 0, 0, 0);
              o = __builtin_amdgcn_mfma_f32_16x16x32_bf16(a1, *(const LAS bf16x8*)(vb + 64), o, 0, 0, 0);
              o = __builtin_amdgcn_mfma_f32_16x16x32_bf16(q0, *(const LAS bf16x8*)(sb), o, 0, 0, 0);
              o = __builtin_amdgcn_mfma_f32_16x16x32_bf16(q1, *(const LAS bf16x8*)(sb + 64), o, 0, 0, 0);
              o = __builtin_amdgcn_mfma_f32_16x16x32_bf16(q2, *(const LAS bf16x8*)(sb + 128), o, 0, 0, 0);
              o = __builtin_amdgcn_mfma_f32_16x16x32_bf16(q3, *(const LAS bf16x8*)(sb + 192), o, 0, 0, 0);
              const int col = h * 64 + 16 * vj + l15;
#pragma unroll
              for (int r = 0; r < 4; ++r) { const size_t row = dir ? row0 - r : row0 + r;
                  if (dir == 0) xc[row * DM + 512 + col] = (bf16_t)f2bf(o[r]); else ob[row * 256 + col] = (bf16_t)f2bf(o[r]); } } }
        { const f32x4 dec = *(const LAS f32x4*)(TOT + 16 * wid + 4 * lq);
          const LAS unsigned char* ka = lds + S_K4T + (16 * wid + l15) * 144 + lq * 16; const bf16x8 k0 = *(const LAS bf16x8*)(ka), k1 = *(const LAS bf16x8*)(ka + 64);
#pragma unroll
          for (int vj = 0; vj < 4; ++vj) { const LAS unsigned char* vb = lds + S_VT + (16 * vj + l15) * 144 + lq * 16;
              f32x4 a = Sacc[vj] * dec;
              a = __builtin_amdgcn_mfma_f32_16x16x32_bf16(k0, *(const LAS bf16x8*)(vb), a, 0, 0, 0);
              a = __builtin_amdgcn_mfma_f32_16x16x32_bf16(k1, *(const LAS bf16x8*)(vb + 64), a, 0, 0, 0);
              Sacc[vj] = a; } }
        __syncthreads();
#pragma unroll
        for (int vj = 0; vj < 4; ++vj) { u32x2 w; w.x = cvt_pk(Sacc[vj][0], Sacc[vj][1]); w.y = cvt_pk(Sacc[vj][2], Sacc[vj][3]);
            *(LAS u32x2*)(lds + S_ST + (16 * vj + l15) * 272 + (16 * wid + 4 * lq) * 2) = w; }
    }
#undef CLOAD
    __syncthreads();
}


#define XB_TMO      128
#define XB_XCNT(j)  (256  + 64 * (j))
#define XB_XSUB(j)  (1280 + 64 * (j))
#define XB_XGEN(j)  (2304 + 64 * (j))
#define XB_TOP      3328
#define XB_TOPGEN   3392
#define XCD_BAR_WORDS 3456
#define XB_SPIN_CAP (1u << 18)
__device__ __forceinline__ unsigned xb_ld(unsigned* p)              { return __hip_atomic_load(p, __ATOMIC_RELAXED, __HIP_MEMORY_SCOPE_AGENT); }
__device__ __forceinline__ unsigned xb_add(unsigned* p, unsigned v) { return __hip_atomic_fetch_add(p, v, __ATOMIC_RELAXED, __HIP_MEMORY_SCOPE_AGENT); }
__device__ __forceinline__ unsigned xb_xcc_id() { return (unsigned)__builtin_amdgcn_s_getreg((3 << 11) | 20) & 0xFu; }
#define XB_SPIN(cond, bar) do { unsigned _sp = 0; while (cond) { __builtin_amdgcn_s_sleep(1); \
    if ((++_sp & 255u) == 0u) { if (xb_ld(&(bar)[XB_TMO])) break; if (_sp > XB_SPIN_CAP) { atomicAdd(&(bar)[XB_TMO], 1u); break; } } } } while (0)
struct XcdBarrier { unsigned* bar; unsigned x; volatile LAS unsigned* st; };
__device__ __forceinline__ XcdBarrier xcd_barrier_post(unsigned* bar, volatile LAS unsigned* st) {
    XcdBarrier b; b.bar = bar; b.x = xb_xcc_id(); b.st = st;
    if (threadIdx.x == 0) (void)xb_add(&bar[XB_XCNT(b.x)], 1u);
    return b;
}
__device__ __forceinline__ void xcd_barrier_complete(unsigned* bar, unsigned x, unsigned& nloc, unsigned& nx) {
    const unsigned G = gridDim.x * gridDim.y * gridDim.z;
    unsigned sum, cnt, mine, sp = 0u;
    for (;;) {
        sum = 0u; cnt = 0u; mine = 0u;
#pragma unroll
        for (unsigned j = 0; j < 16; ++j) { const unsigned c = xb_ld(&bar[XB_XCNT(j)]); sum += c; cnt += (c > 0u) ? 1u : 0u; mine = (j == x) ? c : mine; }
        if (sum == G) break;
        __builtin_amdgcn_s_sleep(1);
        if ((++sp & 255u) == 0u) { if (xb_ld(&bar[XB_TMO])) break; if (sp > XB_SPIN_CAP) { atomicAdd(&bar[XB_TMO], 1u); break; } }
    }
    nloc = mine > 0u ? mine : 1u; nx = cnt > 0u ? cnt : 1u;
}
__device__ __forceinline__ void xcd_barrier(const XcdBarrier& b) {
    asm volatile("s_waitcnt vmcnt(0)" ::: "memory");
    __syncthreads();
    if (threadIdx.x == 0) {
        unsigned* bar = b.bar;
        __builtin_amdgcn_s_waitcnt(0);
        unsigned nloc = b.st[0], nx = b.st[1];
        if (nloc == 0u) { xcd_barrier_complete(bar, b.x, nloc, nx); b.st[0] = nloc; b.st[1] = nx; }
        const unsigned old = xb_add(&bar[XB_XSUB(b.x)], 1u);
        const unsigned gen = old / nloc;
        if (old + 1u == (gen + 1u) * nloc) {
            __builtin_amdgcn_fence(__ATOMIC_RELEASE, "agent");
            asm volatile("s_waitcnt vmcnt(0)" ::: "memory");
            const unsigned og = xb_add(&bar[XB_TOP], 1u);
            const unsigned tg = og / nx;
            if (og + 1u == (tg + 1u) * nx) xb_add(&bar[XB_TOPGEN], 1u);
            else XB_SPIN(xb_ld(&bar[XB_TOPGEN]) == tg, bar);
            __builtin_amdgcn_fence(__ATOMIC_ACQUIRE, "agent");
            xb_add(&bar[XB_XGEN(b.x)], 1u);
            asm volatile("s_waitcnt vmcnt(0)" ::: "memory");
        } else {
            XB_SPIN(xb_ld(&bar[XB_XGEN(b.x)]) == gen, bar);
            __builtin_amdgcn_fence(__ATOMIC_ACQUIRE, "agent");
            asm volatile("s_waitcnt vmcnt(0)" ::: "memory");
        }
    }
    __syncthreads();
}
constexpr int LDS_BARST = 147456 - 64;

struct Args { const float* in[20]; float* out; unsigned char* ws; int ph_lo, ph_hi; };

__device__ __forceinline__ void transpose_item(const float* W, int ldw, int k0, int n0, bf16_t* WT, int ldt, int drow0, LAS float* scr, int lane) {
#pragma unroll 16
    for (int i = 0; i < 32; ++i) { const int kk = 2 * i + (lane >> 5); scr[kk * 33 + (lane & 31)] = W[(size_t)(k0 + kk) * ldw + n0 + (lane & 31)]; }
    asm volatile("s_waitcnt lgkmcnt(0)" ::: "memory");
    const int c = lane & 7;
#pragma unroll
    for (int j = 0; j < 4; ++j) { const int n = (lane >> 3) + 8 * j; const LAS float* s = scr + (8 * c) * 33 + n;
        u32x4 o; o.x = f2bf(s[0]) | (f2bf(s[33]) << 16); o.y = f2bf(s[66]) | (f2bf(s[99]) << 16); o.z = f2bf(s[132]) | (f2bf(s[165]) << 16); o.w = f2bf(s[198]) | (f2bf(s[231]) << 16);
        *(u32x4*)(WT + (size_t)(drow0 + n) * ldt + k0 + 8 * c) = o; }
    asm volatile("s_waitcnt lgkmcnt(0)" ::: "memory");
}

template <int PH> __device__ __forceinline__ void phase_body(const Args& args, LAS unsigned char* lds) {
    const int G = gridDim.x, bx = blockIdx.x;
    const int vcu = (G % 8 == 0) ? (bx % 8) * (G / 8) + bx / 8 : bx;
    unsigned char* ws = args.ws;
    const float* x_in = args.in[0]; const float* c_in = args.in[1]; const float* ctx_in = args.in[2]; const float* cctx = args.in[3];
    const float* w_mod = args.in[4]; const float* b_mod = args.in[5]; const float* n1g = args.in[6]; const float* n2g = args.in[7]; const float* w_in = args.in[8];
    const float* qng = args.in[9]; const float* w_uq = args.in[10]; const float* kvng = args.in[11]; const float* w_ukv = args.in[12]; const float* lbp = args.in[13];
    const float* hgg = args.in[14]; const float* w_fou = args.in[15]; const float* w_out = args.in[16]; const float* w_gu = args.in[17]; const float* w_dn = args.in[18]; const float* fng = args.in[19];
    float* out = args.out;
    bf16_t* WIN = (bf16_t*)(ws + W_WIN); bf16_t* WGU = (bf16_t*)(ws + W_WGU); bf16_t* WDN = (bf16_t*)(ws + W_WDN); bf16_t* WOUT = (bf16_t*)(ws + W_WOUT);
    bf16_t* WS = (bf16_t*)(ws + W_WS);
    bf16_t* DMAT = (bf16_t*)(ws + W_DM); bf16_t* DCM = (bf16_t*)(ws + W_DC); float* COST = (float*)(ws + W_COS); float* SINT = (float*)(ws + W_SIN);
    float* MOD = (float*)(ws + W_MOD); float* STAT = (float*)(ws + W_STAT); bf16_t* OB = (bf16_t*)(ws + W_OB); bf16_t* ZC = (bf16_t*)(ws + W_ZC); bf16_t* ZCC = (bf16_t*)(ws + W_ZCC);
    bf16_t* VT = (bf16_t*)(ws + W_VT); bf16_t* KB = (bf16_t*)(ws + W_K); bf16_t* QB = (bf16_t*)(ws + W_Q); bf16_t* XR = (bf16_t*)args.out;
    bf16_t* XC = (bf16_t*)(ws + W_XC); bf16_t* PB = (bf16_t*)(ws + W_P);

        int tid = threadIdx.x; asm volatile("" : "+v"(tid));
        const int lane = tid & 63; const int wave = __builtin_amdgcn_readfirstlane(tid >> 6);
        const int gw = bx * 8 + wave, NGW = G * 8; const int gt = bx * 512 + tid, NGT = G * 512;
        if constexpr (PH == 0) { if (EN(0)) REP(8) {
            LAS float* scr = (LAS float*)(lds + wave * 8704);
            { constexpr int I_IN = 16 * 86, I_GU = 16 * 176, I_DN = 44 * 32, I_OUT = 12 * 32, PERL = I_IN + I_GU + I_DN + I_OUT;
              for (int it = gw; it < 2 * PERL; it += NGW) { const int l = it / PERL; int r = it - l * PERL;
                  if (r < I_IN) { const int kb = r / 86, nb = r % 86; transpose_item(w_in + (size_t)l * DM * INW, INW, kb * 64, nb * 32, WIN + (size_t)l * INP * DM, DM, nb * 32, scr, lane); continue; } r -= I_IN;
                  if (r < I_GU) { const int kb = r / 176, nb = r % 176; const int n0 = nb * 32, half = n0 >= FF ? 1 : 0, j0 = n0 - half * FF;
                      transpose_item(w_gu + (size_t)l * DM * 5632, 5632, kb * 64, n0, WGU + (size_t)l * 5632 * DM, DM, 256 * (j0 / 128) + half * 128 + (j0 % 128), scr, lane); continue; } r -= I_GU;
                  if (r < I_DN) { const int kb = r / 32, nb = r % 32; transpose_item(w_dn + (size_t)l * FF * DM, DM, kb * 64, nb * 32, WDN + (size_t)l * DM * FF, FF, nb * 32, scr, lane); continue; } r -= I_DN;
                  { const int kb = r / 32, nb = r % 32; transpose_item(w_out + (size_t)l * DM * DM, DM, kb * 64, nb * 32, WOUT + (size_t)l * DM * DM, DM, nb * 32, scr, lane); } } }
            for (int i = gt; i < 2 * 64 * DM / 8; i += NGT) { const int l = i / (64 * DM / 8), r = i % (64 * DM / 8); *(u32x4*)(WIN + (size_t)l * INP * DM + (size_t)INW * DM + r * 8) = (u32x4){0u, 0u, 0u, 0u}; }
            for (int i = gt; i < 2 * 256 * 768; i += NGT) { const int l = i / (256 * 768), r = i % (256 * 768), k = r / 768, n = r % 768;
                WS[(size_t)n * INP + l * 1024 + k] = (bf16_t)f2bf(w_uq[(size_t)l * 256 * 768 + k * 768 + n] * qng[l * 256 + k]);
                const int h = n / 192, d = n % 192; float v;
                if (d < 128) v = k < 128 ? w_ukv[(size_t)l * 128 * 1024 + k * 1024 + h * 256 + d] * kvng[l * 128 + k] : 0.f; else v = (k == d) ? 1.f : 0.f;
                WS[(size_t)n * INP + l * 1024 + 256 + k] = (bf16_t)f2bf(v); }
            for (int i = gt; i < 2 * 256 * 512; i += NGT) { const int l = i / (256 * 512), r = i % (256 * 512), k = r / 512, n = r % 512; const int h = n / 128, d = n % 128;
                const float v = k < 128 ? w_ukv[(size_t)l * 128 * 1024 + k * 1024 + h * 256 + 128 + d] * kvng[l * 128 + k] : 0.f;
                WS[(size_t)n * INP + l * 1024 + 512 + k] = (bf16_t)f2bf(v); }
            for (int i = gt; i < 2 * 256 * 1024; i += NGT) { const int l = i / (256 * 1024), r = i % (256 * 1024), kp = r / 1024, n = r % 1024;
                const float* wf = w_fou + (size_t)l * 256 * 256 + kp * 256; const float* wo = w_out + (size_t)l * DM * DM + (size_t)768 * DM + n; float s = 0.f;
                for (int j = 0; j < 256; ++j) s = fmaf(wf[j], wo[(size_t)j * DM], s);
                WOUT[(size_t)l * DM * DM + (size_t)n * DM + 768 + kp] = (bf16_t)f2bf(s); }
            for (int i = gt; i < 512 * 256; i += NGT) { const int m = i / 256, k = i % 256, np = m >> 1, which = m & 1; float v = 0.f;
                if ((np >> 6) == (k >> 6)) { const int mm = ((np & 63) * (k & 63)) & 63; v = (which ? sinpif((float)mm * (1.f / 32.f)) : cospif((float)mm * (1.f / 32.f))) * 0.125f; }
                WS[(size_t)m * INP + 2048 + k] = (bf16_t)f2bf(v); }
            for (int i = gt; i < TL * TL; i += NGT) { const int tp = i / TL, t = i % TL; const float a = (float)((tp * t) & (TL - 1)) * (1.f / 1024.f);
                DMAT[(size_t)tp * 4096 + t] = (bf16_t)f2bf(cospif(a) * 0.022097086912079608f); DMAT[(size_t)tp * 4096 + TL + t] = (bf16_t)f2bf(-sinpif(a) * 0.022097086912079608f); }
            for (int i = gt; i < TC * TC; i += NGT) { const int tp = i / TC, t = i % TC; const float a = (float)((tp * t) & (TC - 1)) * (1.f / 128.f);
                DCM[tp * 512 + t] = (bf16_t)f2bf(cospif(a) * 0.0625f); DCM[tp * 512 + TC + t] = (bf16_t)f2bf(-sinpif(a) * 0.0625f); }
            for (int i = gt; i < TL * 32; i += NGT) { const int t = i / 32, jj = i % 32, j = jj & 15; const float pos = (float)(jj < 16 ? (t >> 6) : (t & 63));
                const float ang = pos * powf(10000.f, -(float)(2 * j) / 32.f); COST[i] = cosf(ang); SINT[i] = sinf(ang); }
            __syncthreads();
            for (int it = bx; it < 2 * 96; it += G) { const int l = it / 96, n = (it % 96) * 64 + lane; const float* wm = w_mod + (size_t)l * DM * 6144 + n;
                float acc[33];
#pragma unroll
                for (int m = 0; m < 33; ++m) acc[m] = 0.f;
                LAS float* sa = (LAS float*)lds;
#pragma nounroll
                for (int kh = 0; kh < 2; ++kh) {
                    __syncthreads();
#pragma unroll
                    for (int mb_ = 0; mb_ < 2; ++mb_) { float cv[16];
#pragma unroll
                      for (int m = 0; m < 16; ++m) cv[m] = c_in[(mb_ * 16 + m) * DM + kh * 512 + tid];
#pragma unroll
                      for (int m4 = 0; m4 < 4; ++m4) *(LAS f32x4*)(sa + tid * 36 + mb_ * 16 + m4 * 4) = (f32x4){silu_f(cv[m4 * 4]), silu_f(cv[m4 * 4 + 1]), silu_f(cv[m4 * 4 + 2]), silu_f(cv[m4 * 4 + 3])}; }
                    sa[tid * 36 + 32] = silu_f(cctx[kh * 512 + tid]);
                    __syncthreads();
                    for (int kk0 = 0; kk0 < 64; kk0 += 16) { float wv[16];
#pragma unroll
                        for (int u = 0; u < 16; ++u) wv[u] = wm[(size_t)(kh * 512 + wave * 64 + kk0 + u) * 6144];
#pragma unroll
                        for (int u = 0; u < 16; ++u) { const float w = wv[u]; const LAS float* sp = sa + (wave * 64 + kk0 + u) * 36;
#pragma unroll
                            for (int m4 = 0; m4 < 8; ++m4) { const f32x4 s4 = *(const LAS f32x4*)(sp + m4 * 4);
#pragma unroll
                                for (int i = 0; i < 4; ++i) acc[m4 * 4 + i] = fmaf(s4[i], w, acc[m4 * 4 + i]); }
                            acc[32] = fmaf(sp[32], w, acc[32]); } }
                }
                __syncthreads();
                LAS float* red = (LAS float*)lds;
#pragma unroll
                for (int m = 0; m < 33; ++m) red[(wave * 33 + m) * 64 + lane] = acc[m];
                __syncthreads();
                for (int i = tid; i < 33 * 64; i += 512) { const int m = i / 64, nn = i % 64; float s = 0.f;
#pragma unroll
                    for (int w = 0; w < 8; ++w) s += red[(w * 33 + m) * 64 + nn];
                    const int ncol = (it % 96) * 64 + nn; MOD[((size_t)l * 33 + m) * 6144 + ncol] = s + b_mod[l * 6144 + ncol]; }
                __syncthreads();
            }
        } } else if constexpr (PH == NPHASE - 1) { if (EN(9)) {
            for (int R = 4 * gw; R < NB * TL; R += 4 * NGW) { const int b = R / TL, n = R - b * TL; const bf16_t* xs = XC + ((size_t)b * NT + n) * DM + lane * 4; float* xr = out + (size_t)R * DM + lane * 4;
                u32x2 q[4][4]; float rr[4];
#pragma unroll
                for (int rw = 0; rw < 4; ++rw)
#pragma unroll
                    for (int j = 0; j < 4; ++j) q[rw][j] = *(const u32x2*)(xs + (size_t)rw * DM + 256 * j);
#pragma unroll
                for (int rw = 0; rw < 4; ++rw) { float s_ = 0.f;
#pragma unroll
                    for (int j = 0; j < 4; ++j) { const float a0 = bflo(q[rw][j].x), a1 = bfhi(q[rw][j].x), a2 = bflo(q[rw][j].y), a3 = bfhi(q[rw][j].y); s_ += (a0 * a0 + a1 * a1) + (a2 * a2 + a3 * a3); }
                    rr[rw] = rsqrtf(wave_sum(s_) * (1.f / DM) + EPS); }
#pragma unroll
                for (int j = 0; j < 4; ++j) { const f32x4 g4 = *(const f32x4*)(fng + lane * 4 + 256 * j);
#pragma unroll
                    for (int rw = 0; rw < 4; ++rw) { const f32x4 v = (f32x4){bflo(q[rw][j].x), bfhi(q[rw][j].x), bflo(q[rw][j].y), bfhi(q[rw][j].y)};
                        __builtin_nontemporal_store(v * rr[rw] * g4, (f32x4*)(xr + (size_t)rw * DM + 256 * j)); } } }
        } } else {
            constexpr int l = (PH - 1) >> 3, sub = (PH - 1) & 7;
            const float* modl = MOD + (size_t)l * 33 * 6144;
            if ((sub == 0 || sub == 5) && EN(1)) {
                const float* srcL = x_in; const float* srcC = ctx_in;
                const float* gain = (sub == 0 ? n1g : n2g) + l * DM; const int shoff = sub == 0 ? 0 : 3072, scoff = shoff + 1024;
                if (sub == 0 && l == 0) {
                REP(4) for (int R = 4 * gw; R < MR; R += 4 * NGW) { const int b = R / NT, n = R - b * NT; const bool isc = n >= TL;
                    const float* xr = (isc ? srcC + ((size_t)b * TC + n - TL) * DM : srcL + ((size_t)b * TL + n) * DM) + lane * 4; const float* mp = modl + (isc ? 32 : b) * 6144 + lane * 4;
                    f32x4 v[4][4]; float rr[4];
#pragma unroll
                    for (int rw = 0; rw < 4; ++rw)
#pragma unroll
                        for (int j = 0; j < 4; ++j) v[rw][j] = __builtin_nontemporal_load((const f32x4*)(xr + (size_t)rw * DM + 256 * j));
#pragma unroll
                    for (int rw = 0; rw < 4; ++rw) { float s_ = 0.f;
#pragma unroll
                        for (int j = 0; j < 4; ++j) s_ += (v[rw][j][0] * v[rw][j][0] + v[rw][j][1] * v[rw][j][1]) + (v[rw][j][2] * v[rw][j][2] + v[rw][j][3] * v[rw][j][3]);
                        rr[rw] = rsqrtf(wave_sum(s_) * (1.f / DM) + EPS); }
#pragma unroll
                    for (int j = 0; j < 4; ++j) { const f32x4 g4 = *(const f32x4*)(gain + lane * 4 + 256 * j), sc = *(const f32x4*)(mp + scoff + 256 * j) + 1.f, sh = *(const f32x4*)(mp + shoff + 256 * j);
#pragma unroll
                        for (int rw = 0; rw < 4; ++rw) { const f32x4 y = (v[rw][j] * rr[rw] * g4) * sc + sh; u32x2 w; w.x = cvt_pk(y[0], y[1]); w.y = cvt_pk(y[2], y[3]); *(u32x2*)(XC + (size_t)(R + rw) * DM + lane * 4 + 256 * j) = w; } } }
                } else {
                    for (int R = 4 * gw; R < MR; R += 4 * NGW) { const int b = R / NT, n = R - b * NT; const bool isc = n >= TL;
                        if (isc && sub == 5 && l == 1) continue;
                        const bf16_t* xr = XR + (size_t)R * DM + lane * 4; const float* mp = modl + (isc ? 32 : b) * 6144 + lane * 4;
                        u32x2 q[4][4]; float ss[4];
#pragma unroll
                        for (int rw = 0; rw < 4; ++rw)
#pragma unroll
                            for (int j = 0; j < 4; ++j) q[rw][j] = *(const u32x2*)(xr + (size_t)rw * DM + 256 * j);
#pragma unroll
                        for (int rw = 0; rw < 4; ++rw) { float s_ = 0.f;
#pragma unroll
                            for (int j = 0; j < 4; ++j) { const float a0 = bflo(q[rw][j].x), a1 = bfhi(q[rw][j].x), a2 = bflo(q[rw][j].y), a3 = bfhi(q[rw][j].y); s_ += (a0 * a0 + a1 * a1) + (a2 * a2 + a3 * a3); }
                            ss[rw] = rsqrtf(wave_sum(s_) * (1.f / DM) + EPS); }
#pragma unroll
                        for (int j = 0; j < 4; ++j) { const f32x4 g4 = *(const f32x4*)(gain + lane * 4 + 256 * j), sc = *(const f32x4*)(mp + scoff + 256 * j) + 1.f, sh = *(const f32x4*)(mp + shoff + 256 * j); const f32x4 gs = g4 * sc;
#pragma unroll
                            for (int rw = 0; rw < 4; ++rw) { const f32x4 v = (f32x4){bflo(q[rw][j].x), bfhi(q[rw][j].x), bflo(q[rw][j].y), bfhi(q[rw][j].y)}; const f32x4 y = (v * ss[rw]) * gs + sh; u32x2 w;
                                w.x = cvt_pk(y[0], y[1]); w.y = cvt_pk(y[2], y[3]); *(u32x2*)(XC + (size_t)(R + rw) * DM + lane * 4 + 256 * j) = w; } } }
                }
            } else if (sub == 1 && EN(2)) {
                pg8::Gemm g{XC, WIN + (size_t)l * INP * DM, (long)NT * DM, 0, DM, DM, NB, 9, 11};
                pg8::EpiP E{PB, STAT}; REP(3) pg8::gemm_phase(lds, g, G, bx, E);
            } else if (sub == 2 && EN(3)) {
                REP(6) {
                if (EN(10)) { pg8::Gemm g{WS + 2048, PB + O_FN, 0, (long)NT * INP, INP, 256, NB, 2, l == 0 ? 9 : 8};
                  pg8::EpiBf<true> E{ZC, 512L * TL, TL, 0, ZCC, 512L * TC, TC, 8}; pg8::gemm_phase(lds, g, G, bx, E); }
                if (EN(11)) { pg8::Gemm g{PB, WS + l * 1024, (long)NT * INP, 0, INP, 256, NB, l == 0 ? 9 : 8, 3};
                  pg8::EpiQK<true> E{QB, 192, STAT, COST, SINT}; pg8::gemm_phase(lds, g, G, (bx + 64) % G, E); }
                if (EN(12)) { pg8::Gemm g{PB + O_CKV, WS + l * 1024 + 256, (long)NT * INP, 0, INP, 256, NB, 9, 3};
                  pg8::EpiQK<false> E{KB, KP, STAT, COST, SINT}; pg8::gemm_phase(lds, g, G, (bx + 160) % G, E); }
                if (EN(13)) { pg8::Gemm g{WS + l * 1024 + 512, PB + O_CKV, 0, (long)NT * INP, INP, 256, NB, 2, 9};
                  pg8::EpiVt E{VT, STAT}; pg8::gemm_phase(lds, g, G, bx, E); }
                }
                if (EN(14)) REP(0) for (int j = bx; j < NB * 8; j += G) scan_job(lds, j >> 3, (j >> 1) & 3, j & 1, l, PB, lbp, XC, OB);
            } else if (sub == 3 && EN(4)) {
                if (EN(15)) { pg8::Gemm g{DMAT, ZC, 0, 512L * TL, 4096, 4096, NB, 8, 1};
                  pg8::EpiBf<true> E{XC, (long)NT * DM, DM, 768, XC, 0, DM, 1 << 30}; REP(5) pg8::gemm_phase(lds, g, G, bx, E); }
                if (l == 0 && EN(16)) { pg8::Gemm g{DCM, ZCC, 0, 512L * TC, 512, 512, NB, 1, 1};
                  pg8::EpiBf<true> E{XC + (size_t)TL * DM, (long)NT * DM, DM, 768, XC, 0, DM, 1 << 30}; pg8::gemm_phase(lds, g, G, bx, E); }
                __syncthreads();
                if (EN(17)) { const int nun = NB * 4 * 8 + (l == 0 ? NB * 4 : 0);
                  REP(1) for (int un = vcu; un < nun; un += G) {
                      if (un < NB * 32) { const int bh = un >> 3, qb = un & 7; attn_unit(lds, bh >> 2, bh & 3, qb * 256, 0, NT / 64, QB, KB, VT, XC); }
                      else { const int bh = un - NB * 32; attn_unit(lds, bh >> 2, bh & 3, TL, TL, TC / 64, QB, KB, VT, XC); } } }
                if (EN(18)) for (int R0 = 2 * gw; R0 < MR; R0 += 2 * NGW) { const int b = R0 / NT, n = R0 - b * NT; if (n >= TL && l == 1) continue;
                    const int col = lane * 4; const f32x4 g4 = *(const f32x4*)(hgg + l * 256 + col);
                    u32x2 fw[2], bw[2], zw[2];
#pragma unroll
                    for (int q = 0; q < 2; ++q) { const size_t R = (size_t)R0 + q; fw[q] = *(const u32x2*)(XC + R * DM + 512 + col); bw[q] = *(const u32x2*)(OB + R * 256 + col); zw[q] = *(const u32x2*)(PB + R * INP + O_HG + col); }
#pragma unroll
                    for (int q = 0; q < 2; ++q) { const size_t R = (size_t)R0 + q;
                        float o[4] = {bflo(fw[q].x) + bflo(bw[q].x), bfhi(fw[q].x) + bfhi(bw[q].x), bflo(fw[q].y) + bflo(bw[q].y), bfhi(fw[q].y) + bfhi(bw[q].y)};
                        float ss = (o[0] * o[0] + o[1] * o[1]) + (o[2] * o[2] + o[3] * o[3]);
                        ss += __shfl_xor(ss, 1); ss += __shfl_xor(ss, 2); ss += __shfl_xor(ss, 4); ss += __shfl_xor(ss, 8);
                        const float r = rsqrtf(ss * (1.f / 64.f) + EPS);
                        const float z[4] = {bflo(zw[q].x), bfhi(zw[q].x), bflo(zw[q].y), bfhi(zw[q].y)}; float y[4];
#pragma unroll
                        for (int i = 0; i < 4; ++i) y[i] = o[i] * r * g4[i] * silu_f(z[i]);
                        u32x2 w; w.x = cvt_pk(y[0], y[1]); w.y = cvt_pk(y[2], y[3]); *(u32x2*)(XC + R * DM + 512 + col) = w; } }
            } else if (sub == 4 && EN(5)) {
                pg8::Gemm g{XC, WOUT + (size_t)l * DM * DM, (long)NT * DM, 0, DM, DM, NB, l == 0 ? 9 : 8, 4};
                pg8::EpiRes<l == 0> E{x_in, ctx_in, XR, XR, modl + 2048}; pg8::gemm_phase(lds, g, G, bx, E);
            } else if (sub == 6 && EN(6)) {
                pg8::Gemm g{XC, WGU + (size_t)l * 5632 * DM, (long)NT * DM, 0, DM, DM, NB, l == 0 ? 9 : 8, 22};
                pg8::EpiGU E{PB}; REP(2) pg8::gemm_phase(lds, g, G, bx, E);
            } else if (sub == 7 && EN(7)) {
                pg8::Gemm g{PB, WDN + (size_t)l * DM * FF, (long)NT * FF, 0, FF, FF, NB, l == 0 ? 9 : 8, 4};
                pg8::EpiRes<false> E{x_in, ctx_in, XR, l == 0 ? XR : XC, modl + 5120}; pg8::gemm_phase(lds, g, G, bx, E);
            }
        }
}

__global__ void __launch_bounds__(512, 2) mk_fwd(Args args) {
    extern __shared__ __attribute__((aligned(16))) unsigned char lds_raw[];
    LAS unsigned char* lds = (LAS unsigned char*)lds_raw;
    XcdBarrier bar; bar.bar = (unsigned*)(args.ws + W_CTL); bar.x = 0; bar.st = nullptr;
    if (args.ph_hi - args.ph_lo > 1) {
        if (threadIdx.x < 2) ((volatile LAS unsigned*)(lds + LDS_BARST))[threadIdx.x] = 0u;
        __syncthreads();
        bar = xcd_barrier_post((unsigned*)(args.ws + W_CTL), (volatile LAS unsigned*)(lds + LDS_BARST));
    }
#define PHASE(k) if (args.ph_lo <= (k) && (k) < args.ph_hi) { phase_body<k>(args, lds); if ((k) + 1 < args.ph_hi) { if (args.ph_hi > 1000) cg::this_grid().sync(); else xcd_barrier(bar); } }
    PHASE(0) PHASE(1) PHASE(2) PHASE(3) PHASE(4) PHASE(5) PHASE(6) PHASE(7) PHASE(8) PHASE(9) PHASE(10) PHASE(11) PHASE(12) PHASE(13) PHASE(14) PHASE(15) PHASE(16) PHASE(17)
#undef PHASE
}

extern "C" void kernel_launch(void* const* d_in, const int* in_sizes, int n_in, void* d_out, int out_size, void* d_ws, size_t ws_size, hipStream_t stream) {
    static int grid = 0;
    if (grid == 0) {
        if (n_in != 20 || out_size != NB * TL * DM || ws_size < W_END) { fprintf(stderr, "kernel_launch: unexpected problem (n_in %d out %d ws %zu need %zu)\n", n_in, out_size, ws_size, (size_t)W_END); grid = -1; return; }
        int dev = 0, cus = 0, per_cu = 0;
        hipGetDevice(&dev); hipDeviceGetAttribute(&cus, hipDeviceAttributeMultiprocessorCount, dev);
        if (hipFuncSetAttribute((const void*)mk_fwd, hipFuncAttributeMaxDynamicSharedMemorySize, LDS_BYTES) != hipSuccess) { fprintf(stderr, "kernel_launch: hipFuncSetAttribute failed\n"); grid = -1; return; }
        if (hipOccupancyMaxActiveBlocksPerMultiprocessor(&per_cu, (const void*)mk_fwd, 512, LDS_BYTES) != hipSuccess || per_cu < 1) { fprintf(stderr, "kernel_launch: occupancy query gave %d\n", per_cu); per_cu = 1; }
        (void)hipGetLastError();
        grid = cus * (per_cu > 1 ? 1 : per_cu);
        if (grid <= 0) grid = 256;
    }
    if (grid < 0) return;
    Args a{};
    for (int i = 0; i < 20; ++i) a.in[i] = (const float*)d_in[i];
    a.out = (float*)d_out; a.ws = (unsigned char*)d_ws;
#if MK_MULTI
    for (int ph = 0; ph < NPHASE; ++ph) { a.ph_lo = ph; a.ph_hi = ph + 1; hipLaunchKernelGGL(mk_fwd, dim3(grid), dim3(512), LDS_BYTES, stream, a); }
#else
    a.ph_lo = 0; a.ph_hi = NPHASE;
    if (hipMemsetAsync((char*)d_ws + W_CTL, 0, CTL_BYTES, stream) != hipSuccess) { fprintf(stderr, "kernel_launch: memset failed\n"); return; }
    void* kargs[] = {&a};
    hipError_t e = hipLaunchCooperativeKernel((const void*)mk_fwd, dim3(grid), dim3(512), kargs, LDS_BYTES, stream);
    if (e != hipSuccess) fprintf(stderr, "kernel_launch: cooperative launch failed: %s (grid %d)\n", hipGetErrorString(e), grid);
#endif
}
```
